# Optimizing an MI355X kernel written in HIP

```python
import jax, jax.numpy as jnp
from jax import lax
import numpy as np

D_MODEL = 1024
BATCH = 2
SEQ = 16384
DEPTH = 2

N_MIXERS = 2
N_HEADS = 16
HEAD_DIM = D_MODEL // N_HEADS
MOBA_BLOCK = 256
MOBA_TOPK = 3
Q_CHUNK = 32
ROPE_THETA = 10000.0
CONV_WIDTH = 3
D_FF = 2816
RMS_EPS = 1e-6
NEG_INF = -1e30
N_CONV_LAYERS = (DEPTH + 1) // 2
N_ATTN_LAYERS = DEPTH // 2

kernel_name = "hybrid_shortconv_moba_convffn"


def rmsnorm(x, g):
    xf = x.astype(jnp.float32)
    var = jnp.mean(xf * xf, axis=-1, keepdims=True)
    return (xf * lax.rsqrt(var + RMS_EPS)).astype(x.dtype) * g


def causal_dwconv(x, w):
    S = x.shape[1]
    xp = jnp.pad(x, ((0, 0), (CONV_WIDTH - 1, 0), (0, 0)))
    y = xp[:, 0:S] * w[0]
    for j in range(1, CONV_WIDTH):
        y = y + xp[:, j:j + S] * w[j]
    return y


def short_conv_mixer(h, w_in, w_conv, w_out):
    bcv = h @ w_in
    b, c, v = jnp.split(bcv, 3, axis=-1)
    return (b * causal_dwconv(c * v, w_conv)) @ w_out


def rope(x, pos):
    half = HEAD_DIM // 2
    inv = ROPE_THETA ** (-jnp.arange(half, dtype=jnp.float32) / half)
    ang = pos.astype(jnp.float32)[:, None] * inv[None, :]
    cos = jnp.cos(ang).astype(x.dtype)
    sin = jnp.sin(ang).astype(x.dtype)
    x1, x2 = x[..., :half], x[..., half:]
    return jnp.concatenate([x1 * cos - x2 * sin, x2 * cos + x1 * sin], axis=-1)


def moba_attention(h, w_qkv, w_o):
    Bsz, S, _ = h.shape
    qkv = (h @ w_qkv).reshape(Bsz, S, 3, N_HEADS, HEAD_DIM)
    q = jnp.transpose(qkv[:, :, 0], (0, 2, 1, 3))
    k = jnp.transpose(qkv[:, :, 1], (0, 2, 1, 3))
    v = jnp.transpose(qkv[:, :, 2], (0, 2, 1, 3))
    pos = jnp.arange(S, dtype=jnp.int32)
    q = rope(q, pos) * (HEAD_DIM ** -0.5)
    k = rope(k, pos)

    n_blocks = -(-S // MOBA_BLOCK)
    pad = n_blocks * MOBA_BLOCK - S
    k = jnp.pad(k, ((0, 0), (0, 0), (0, pad), (0, 0)))
    v = jnp.pad(v, ((0, 0), (0, 0), (0, pad), (0, 0)))
    k_blocks = k.reshape(Bsz, N_HEADS, n_blocks, MOBA_BLOCK, HEAD_DIM)
    v_blocks = v.reshape(Bsz, N_HEADS, n_blocks, MOBA_BLOCK, HEAD_DIM)
    k_mean = jnp.mean(k_blocks.astype(jnp.float32), axis=3).astype(k.dtype)

    topk = min(MOBA_TOPK, n_blocks)
    b_idx = jnp.arange(Bsz)[:, None, None, None]
    h_idx = jnp.arange(N_HEADS)[None, :, None, None]
    block_ids = jnp.arange(n_blocks)
    key_off = jnp.arange(MOBA_BLOCK)
    q_off = jnp.arange(Q_CHUNK)

    def chunk(c):
        q0 = c * Q_CHUNK
        qc = lax.dynamic_slice_in_dim(q, q0, Q_CHUNK, axis=2)
        qpos = q0 + q_off
        own = q0 // MOBA_BLOCK
        gate = jnp.einsum('bhqd,bhnd->bhqn', qc, k_mean).astype(jnp.float32)
        gate = jnp.where((block_ids < own)[None, None, None, :], gate, NEG_INF)
        _, top_i = lax.top_k(gate, topk)
        rank_valid = jnp.arange(topk) < jnp.minimum(own, MOBA_TOPK)
        kg = k_blocks[b_idx, h_idx, top_i]
        vg = v_blocks[b_idx, h_idx, top_i]
        s_sel = jnp.einsum('bhqd,bhqnjd->bhqnj', qc, kg).astype(jnp.float32)
        s_sel = jnp.where(rank_valid[:, None], s_sel, NEG_INF)
        s_sel = s_sel.reshape(Bsz, N_HEADS, Q_CHUNK, topk * MOBA_BLOCK)
        ko = lax.dynamic_slice_in_dim(k, own * MOBA_BLOCK, MOBA_BLOCK, axis=2)
        vo = lax.dynamic_slice_in_dim(v, own * MOBA_BLOCK, MOBA_BLOCK, axis=2)
        s_own = jnp.einsum('bhqd,bhjd->bhqj', qc, ko).astype(jnp.float32)
        kpos = own * MOBA_BLOCK + key_off
        s_own = jnp.where(kpos[None, :] <= qpos[:, None], s_own, NEG_INF)
        p = jax.nn.softmax(jnp.concatenate([s_sel, s_own], axis=-1), axis=-1).astype(v.dtype)
        p_sel = p[..., :topk * MOBA_BLOCK].reshape(Bsz, N_HEADS, Q_CHUNK, topk, MOBA_BLOCK)
        p_own = p[..., topk * MOBA_BLOCK:]
        return (jnp.einsum('bhqnj,bhqnjd->bhqd', p_sel, vg)
                + jnp.einsum('bhqj,bhjd->bhqd', p_own, vo))

    o = lax.map(chunk, jnp.arange(S // Q_CHUNK))
    o = jnp.transpose(o, (1, 0, 3, 2, 4)).reshape(Bsz, S, N_HEADS * HEAD_DIM)
    return o @ w_o


def conv_ffn(h, w_up, w_conv, w_down):
    gu = causal_dwconv(h @ w_up, w_conv)
    g, u = jnp.split(gu, 2, axis=-1)
    return (jax.nn.silu(g) * u) @ w_down


def setup_inputs(seed: int = 0) -> dict:
    key = jax.random.key(seed)
    ks = jax.random.split(key, 16)
    D = D_MODEL
    f32 = jnp.float32

    def nrm(k, shape, scale):
        return jax.random.normal(k, shape, dtype=f32) * scale

    return {
        "x": nrm(ks[0], (BATCH, SEQ, D), 1.0),
        "mix_norm": 1.0 + nrm(ks[1], (DEPTH, D), 0.02),
        "sc_w_in": nrm(ks[2], (N_CONV_LAYERS, D, 3 * D), D ** -0.5),
        "sc_w_conv": nrm(ks[3], (N_CONV_LAYERS, CONV_WIDTH, D), CONV_WIDTH ** -0.5),
        "sc_w_out": nrm(ks[4], (N_CONV_LAYERS, D, D), D ** -0.5),
        "moba_w_qkv": nrm(ks[5], (N_ATTN_LAYERS, D, 3 * D), D ** -0.5),
        "moba_w_o": nrm(ks[6], (N_ATTN_LAYERS, D, D), D ** -0.5),
        "ffn_norm": 1.0 + nrm(ks[7], (DEPTH, D), 0.02),
        "ffn_w_up": nrm(ks[8], (DEPTH, D, 2 * D_FF), D ** -0.5),
        "ffn_w_conv": nrm(ks[9], (DEPTH, CONV_WIDTH, 2 * D_FF), CONV_WIDTH ** -0.5),
        "ffn_w_down": nrm(ks[10], (DEPTH, D_FF, D), D_FF ** -0.5),
        "final_norm": 1.0 + nrm(ks[11], (D,), 0.02),
    }


def reference(x, mix_norm, sc_w_in, sc_w_conv, sc_w_out, moba_w_qkv, moba_w_o,
              ffn_norm, ffn_w_up, ffn_w_conv, ffn_w_down, final_norm):
    for i in range(DEPTH):
        h = rmsnorm(x, mix_norm[i])
        j = i // N_MIXERS
        if i % N_MIXERS == 0:
            x = x + short_conv_mixer(h, sc_w_in[j], sc_w_conv[j], sc_w_out[j])
        else:
            x = x + moba_attention(h, moba_w_qkv[j], moba_w_o[j])
        x = x + conv_ffn(rmsnorm(x, ffn_norm[i]), ffn_w_up[i], ffn_w_conv[i], ffn_w_down[i])
    return rmsnorm(x, final_norm)
```

```cpp
#include <hip/hip_runtime.h>
#include <hip/hip_cooperative_groups.h>
#include <cstdio>
#include <cstdint>
namespace cg = cooperative_groups;
namespace pg8 {
#define PG8_LAS __attribute__((address_space(3)))
typedef unsigned short bf16_t;
typedef short bf16x8 __attribute__((ext_vector_type(8)));
typedef float f32x4 __attribute__((ext_vector_type(4)));
typedef unsigned u32x4 __attribute__((ext_vector_type(4)));
constexpr int BM = 256, BK = 64, HALF = 128, HTB = HALF * BK * 2  , STAGE_BYTES = 8 * HTB, NXCD = 8, WGM = 8;

__host__ __device__ __forceinline__ int lds_byte(int r, int c) { const int st = (r >> 4) * 2 + (c >> 5), rr = r & 15, cc = c & 31, ob = rr * 64 + cc * 2; return st * 1024 + (ob ^ (((ob >> 9) & 1) << 5)); }
__host__ __device__ __forceinline__ void stage_rc(int b, int& R, int& C) { const int st = b / 1024, sb = b % 1024, swz = sb ^ (((sb >> 9) & 1) << 5); R = (st >> 1) * 16 + swz / 64; C = (st & 1) * 32 + (swz % 64) / 2; }
__host__ __device__ __forceinline__ int perm32(int rho) { const int n = rho >> 4, i = rho & 15; return 8 * (i >> 2) + 4 * n + (i & 3); }

struct Unit { int pm, pn, i; };
struct Gemm { const bf16_t* A; const bf16_t* Bt; int M, N, K, lda; };

struct StaticOrder {
    int nM, nN, nwg, G, c; const float* ssq; PG8_LAS float* tab;
    __host__ __device__ void init(int M, int N, int G_, int c_, const float* ssq_ = nullptr, PG8_LAS float* tab_ = nullptr) { nM = M / BM; nN = N / BM; nwg = nM * nN; G = G_; c = c_; ssq = ssq_; tab = tab_; }
    __host__ __device__ bool next(int i, Unit& u) const {
        const long L = (long)i * G + c; if (L >= nwg) return false;
        int wgid = (int)L; { const int q = nwg / NXCD, r = nwg % NXCD, xcd = wgid % NXCD, off = wgid / NXCD; wgid = (xcd < r ? xcd * (q + 1) : r * (q + 1) + (xcd - r) * q) + off; }
        const int nig = WGM * nN, gid = wgid / nig, fm = gid * WGM, gsz = (nM - fm) < WGM ? (nM - fm) : WGM;
        u.pm = fm + ((wgid % nig) % gsz); u.pn = (wgid % nig) / gsz; u.i = i; return true;
    }
    __device__ __forceinline__ void a_ready(const Unit& u) const {
        if (ssq) { int t_ = threadIdx.x; asm volatile("" : "+v"(t_)); const int t = t_, r = t >> 1, hf = t & 1; const f32x4* p = (const f32x4*)(ssq + (size_t)(u.pm * BM + r) * 16 + hf * 8); const f32x4 a = p[0], b = p[1];
            float s = ((a[0] + a[1]) + (a[2] + a[3])) + ((b[0] + b[1]) + (b[2] + b[3])); s += __shfl_xor(s, 1);
            if (hf == 0) tab[(u.i & 1) * BM + r] = __builtin_amdgcn_rsqf(s * (1.0f / 1024.0f) + 1e-6f); }
    }
    __device__ __forceinline__ void done(const Unit&) const {}
};

__device__ __forceinline__ unsigned cvt_pk_bf16(float lo, float hi) { unsigned r; asm volatile("v_cvt_pk_bf16_f32 %0, %1, %2" : "=v"(r) : "v"(lo), "v"(hi)); return r; }
typedef float f32x2 __attribute__((ext_vector_type(2)));
__device__ __forceinline__ u32x4 pack8(f32x4 v0, f32x4 v1) { u32x4 w; w.x = cvt_pk_bf16(v0[0], v0[1]); w.y = cvt_pk_bf16(v0[2], v0[3]); w.z = cvt_pk_bf16(v1[0], v1[1]); w.w = cvt_pk_bf16(v1[2], v1[3]); return w; }
__device__ __forceinline__ float row_rstd(const float* ssq, int row) {
    const f32x4* p = (const f32x4*)(ssq + (size_t)row * 16);
    const f32x4 a = p[0], b = p[1], c = p[2], d = p[3];
    const float s = (((a[0] + a[1]) + (a[2] + a[3])) + ((b[0] + b[1]) + (b[2] + b[3]))) + (((c[0] + c[1]) + (c[2] + c[3])) + ((d[0] + d[1]) + (d[2] + d[3])));
    return __builtin_amdgcn_rsqf(s * (1.0f / 1024.0f) + 1e-6f);
}
struct EpiCV {
    static constexpr bool PERM = true, AFTER_DRAIN = false;
    const PG8_LAS float* tab; bf16_t* CV;
    __device__ __forceinline__ void operator()(const f32x4 (&acc)[2][2][4][2], const Unit& u, int wr, int wc, int fr, int fq) const {
        const int row0 = u.pm * BM + wr * 64 + fr;
#pragma unroll
        for (int ai = 0; ai < 2; ++ai)
#pragma unroll
            for (int m = 0; m < 4; ++m) { const int row = row0 + ai * HALF + m * 16; const float rs = tab[(u.i & 1) * BM + ai * HALF + wr * 64 + m * 16 + fr]; const float r2 = rs * rs;
                *(u32x4*)(CV + (size_t)row * 1024 + u.pn * HALF + wc * 32 + 8 * fq) = pack8(acc[ai][0][m][0] * acc[ai][1][m][0] * r2, acc[ai][0][m][1] * acc[ai][1][m][1] * r2);
                if (m & 1) asm volatile("" ::: "memory"); }
    }
};
struct EpiGate {
    static constexpr bool PERM = true, AFTER_DRAIN = false;
    const PG8_LAS float* tab; const bf16_t* CV; const float* wconv; bf16_t* Y1;
    __device__ __forceinline__ void operator()(const f32x4 (&acc)[2][2][4][2], const Unit& u, int wr, int wc, int fr, int fq) const {
        const int row0 = u.pm * BM + wr * 64 + fr;
#pragma unroll
        for (int bj = 0; bj < 2; ++bj) { const int col = u.pn * 256 + bj * HALF + wc * 32 + 8 * fq;
            f32x4 w0[2], w1[2], w2[2];
#pragma unroll
            for (int n = 0; n < 2; ++n) { w0[n] = *(const f32x4*)(wconv + col + 4 * n); w1[n] = *(const f32x4*)(wconv + 1024 + col + 4 * n); w2[n] = *(const f32x4*)(wconv + 2048 + col + 4 * n); }
#pragma unroll
            for (int ai = 0; ai < 2; ++ai)
#pragma unroll
                for (int m = 0; m < 4; ++m) { const int row = row0 + ai * HALF + m * 16; const float rs = tab[(u.i & 1) * BM + ai * HALF + wr * 64 + m * 16 + fr]; const int sq = row & 16383;
                    const bf16_t* cp = CV + (size_t)row * 1024 + col;
                    const u32x4 c0 = *(const u32x4*)cp; u32x4 c1 = {0u, 0u, 0u, 0u}, c2 = c1;
                    if (sq >= 1) c1 = *(const u32x4*)(cp - 1024); if (sq >= 2) c2 = *(const u32x4*)(cp - 2048);
                    f32x4 y[2];
#pragma unroll
                    for (int n = 0; n < 2; ++n)
#pragma unroll
                        for (int i = 0; i < 4; ++i) { const int k = 2 * n + (i >> 1); const bool hi_ = i & 1;
                            const float x0 = __uint_as_float(hi_ ? (c0[k] & 0xffff0000u) : (c0[k] << 16)), x1 = __uint_as_float(hi_ ? (c1[k] & 0xffff0000u) : (c1[k] << 16)), x2 = __uint_as_float(hi_ ? (c2[k] & 0xffff0000u) : (c2[k] << 16));
                            y[n][i] = acc[ai][bj][m][n][i] * rs * (w0[n][i] * x2 + w1[n][i] * x1 + w2[n][i] * x0); }
                    *(u32x4*)(Y1 + (size_t)row * 1024 + col) = pack8(y[0], y[1]);
                    if (m == 3) asm volatile("" ::: "memory"); } }
    }
};
template <bool RESF32> struct EpiRes {
    static constexpr bool PERM = true, AFTER_DRAIN = false;
    const float* resf; bf16_t* xb; float* ssq;
    __device__ __forceinline__ void operator()(const f32x4 (&acc)[2][2][4][2], const Unit& u, int wr, int wc, int fr, int fq) const {
        const int row0 = u.pm * BM + wr * 64 + fr;
#pragma unroll
        for (int ai = 0; ai < 2; ++ai) {
            u32x4 pre[2][4][2];
            if (!RESF32) {
#pragma unroll
                for (int m = 0; m < 4; ++m)
#pragma unroll
                    for (int bj = 0; bj < 2; ++bj) pre[ai][m][bj] = *(const u32x4*)(xb + (size_t)(row0 + ai * HALF + m * 16) * 1024 + u.pn * 256 + bj * HALF + wc * 32 + 8 * fq);
            }
#pragma unroll
            for (int m = 0; m < 4; ++m) { const int row = row0 + ai * HALF + m * 16; float s = 0.f;
#pragma unroll
                for (int bj = 0; bj < 2; ++bj) { const size_t off = (size_t)row * 1024 + u.pn * 256 + bj * HALF + wc * 32 + 8 * fq;
                    f32x4 r0, r1;
                    if (RESF32) { r0 = *(const f32x4*)(resf + off); r1 = *(const f32x4*)(resf + off + 4); }
                    else { const u32x4 w = pre[ai][m][bj]; r0 = (f32x4){__uint_as_float(w.x << 16), __uint_as_float(w.x & 0xffff0000u), __uint_as_float(w.y << 16), __uint_as_float(w.y & 0xffff0000u)};
                           r1 = (f32x4){__uint_as_float(w.z << 16), __uint_as_float(w.z & 0xffff0000u), __uint_as_float(w.w << 16), __uint_as_float(w.w & 0xffff0000u)}; }
                    const f32x4 v0 = r0 + acc[ai][bj][m][0], v1 = r1 + acc[ai][bj][m][1];
                    *(u32x4*)(xb + off) = pack8(v0, v1);
                    s += ((v0[0] * v0[0] + v0[1] * v0[1]) + (v0[2] * v0[2] + v0[3] * v0[3])) + ((v1[0] * v1[0] + v1[1] * v1[1]) + (v1[2] * v1[2] + v1[3] * v1[3])); }
                s += __shfl_xor(s, 16); s += __shfl_xor(s, 32);
                if (fq == 0) ssq[(size_t)row * 16 + u.pn * 4 + wc] = s;
                if (RESF32 && (m & 1)) asm volatile("" ::: "memory"); }
            asm volatile("" ::: "memory"); }
    }
};
__device__ __forceinline__ float dpp_shr1(float v, float old) { return __int_as_float(__builtin_amdgcn_update_dpp(__float_as_int(old), __float_as_int(v), 0x111, 0xf, 0xf, false)); }
__device__ __forceinline__ float dpp_shr2(float v, float old) { return __int_as_float(__builtin_amdgcn_update_dpp(__float_as_int(old), __float_as_int(v), 0x112, 0xf, 0xf, false)); }
__device__ __forceinline__ float dpp_ror1(float v) { return __int_as_float(__builtin_amdgcn_update_dpp(0, __float_as_int(v), 0x121, 0xf, 0xf, false)); }
__device__ __forceinline__ float dpp_ror2(float v) { return __int_as_float(__builtin_amdgcn_update_dpp(0, __float_as_int(v), 0x122, 0xf, 0xf, false)); }
struct EpiUpAct {
    static constexpr bool PERM = true, AFTER_DRAIN = false;
    const PG8_LAS float* tab; bf16_t* ACT; bf16_t* RAW; const float* wconv;
    __device__ __forceinline__ void operator()(const f32x4 (&acc)[2][2][4][2], const Unit& u, int wr, int wc, int fr, int fq) const {
        typedef unsigned u32x2 __attribute__((ext_vector_type(2)));
        const int row0 = u.pm * BM + wr * 64 + fr; const int cb = u.pn * HALF + wc * 32 + 8 * fq;
        float rs[8];
#pragma unroll
        for (int q = 0; q < 8; ++q) rs[q] = tab[(u.i & 1) * BM + (q >> 2) * HALF + wr * 64 + (q & 3) * 16 + fr];
        u32x2 a0[8];
#pragma unroll
        for (int n = 0; n < 2; ++n) {
            f32x4 wg[3], wu[3];
#pragma unroll
            for (int j = 0; j < 3; ++j) { wg[j] = *(const f32x4*)(wconv + j * 5632 + cb + 4 * n); wu[j] = *(const f32x4*)(wconv + j * 5632 + 2816 + cb + 4 * n); }
#pragma unroll
            for (int ai = 0; ai < 2; ++ai)
#pragma unroll
                for (int m = 0; m < 4; ++m) { const int q = ai * 4 + m; const int row = row0 + ai * HALF + m * 16;
                    const f32x4 g = acc[ai][0][m][n] * rs[q], uu = acc[ai][1][m][n] * rs[q];
                    f32x4 pg = {0.f, 0.f, 0.f, 0.f}, pu = pg; if (m > 0) { pg = acc[ai][0][m - 1][n] * rs[q - 1]; pu = acc[ai][1][m - 1][n] * rs[q - 1]; }
                    f32x4 a;
#pragma unroll
                    for (int i = 0; i < 4; i += 2) {
                        typedef float f32x2v __attribute__((ext_vector_type(2)));
                        const f32x2v G = {g[i], g[i + 1]}, U = {uu[i], uu[i + 1]};
                        const f32x2v G1 = {dpp_shr1(g[i], dpp_ror1(pg[i])), dpp_shr1(g[i + 1], dpp_ror1(pg[i + 1]))}, G2 = {dpp_shr2(g[i], dpp_ror2(pg[i])), dpp_shr2(g[i + 1], dpp_ror2(pg[i + 1]))};
                        const f32x2v U1 = {dpp_shr1(uu[i], dpp_ror1(pu[i])), dpp_shr1(uu[i + 1], dpp_ror1(pu[i + 1]))}, U2 = {dpp_shr2(uu[i], dpp_ror2(pu[i])), dpp_shr2(uu[i + 1], dpp_ror2(pu[i + 1]))};
                        const f32x2v gc = (f32x2v){wg[0][i], wg[0][i + 1]} * G2 + (f32x2v){wg[1][i], wg[1][i + 1]} * G1 + (f32x2v){wg[2][i], wg[2][i + 1]} * G;
                        const f32x2v uc = (f32x2v){wu[0][i], wu[0][i + 1]} * U2 + (f32x2v){wu[1][i], wu[1][i + 1]} * U1 + (f32x2v){wu[2][i], wu[2][i + 1]} * U;
                        f32x2v e = gc * -1.4426950408889634f; e.x = __builtin_amdgcn_exp2f(e.x); e.y = __builtin_amdgcn_exp2f(e.y); e = e + 1.0f; e.x = __builtin_amdgcn_rcpf(e.x); e.y = __builtin_amdgcn_rcpf(e.y);
                        const f32x2v av = gc * e * uc; a[i] = av.x; a[i + 1] = av.y; }
                    const u32x2 pk = {cvt_pk_bf16(a[0], a[1]), cvt_pk_bf16(a[2], a[3])};
                    if (n == 0) a0[q] = pk;
                    else if (!(m == 0 && fr < 2)) *(u32x4*)(ACT + (size_t)row * 2816 + cb) = (u32x4){a0[q].x, a0[q].y, pk.x, pk.y};
                    if ((m == 0 && fr < 2) || (m == 3 && fr >= 14)) { const int slot = m == 0 ? fr : fr - 12; bf16_t* rp = RAW + ((size_t)(row >> 6) * 4 + slot) * 5632 + cb + 4 * n;
                        *(u32x2*)rp = (u32x2){cvt_pk_bf16(g[0], g[1]), cvt_pk_bf16(g[2], g[3])}; *(u32x2*)(rp + 2816) = (u32x2){cvt_pk_bf16(uu[0], uu[1]), cvt_pk_bf16(uu[2], uu[3])}; }
                    if (m & 1) asm volatile("" ::: "memory"); }
        }
    }
};
struct EpiQkv {
    static constexpr bool PERM = true, AFTER_DRAIN = false;
    const PG8_LAS float* tab; bf16_t* Q; bf16_t* Kb; bf16_t* V; const float* ropeC; const float* ropeS; float* kmean;
    __device__ __forceinline__ void operator()(const f32x4 (&acc)[2][2][4][2], const Unit& u, int wr, int wc, int fr, int fq) const {
        const int row0 = u.pm * BM + wr * 64 + fr; const int which = u.pn >> 2;
        if (which == 2) {
#pragma unroll
            for (int ai = 0; ai < 2; ++ai)
#pragma unroll
                for (int m = 0; m < 4; ++m) { const int row = row0 + ai * HALF + m * 16; const float rs = tab[(u.i & 1) * BM + ai * HALF + wr * 64 + m * 16 + fr];
#pragma unroll
                    for (int bj = 0; bj < 2; ++bj) *(u32x4*)(V + (size_t)row * 1024 + (u.pn - 8) * 256 + bj * HALF + wc * 32 + 8 * fq) = pack8(acc[ai][bj][m][0] * rs, acc[ai][bj][m][1] * rs);
                    if (m & 1) asm volatile("" ::: "memory"); }
        } else {
            bf16_t* dst = which == 0 ? Q : Kb; const float sc = which == 0 ? 0.125f * 1.4426950408889634f : 1.0f; const int head = (u.pn & 3) * 4 + wc;
            f32x4 ks0 = {0.f, 0.f, 0.f, 0.f}, ks1 = ks0, ks2 = ks0, ks3 = ks0;
#pragma unroll
            for (int ai = 0; ai < 2; ++ai)
#pragma unroll
                for (int m = 0; m < 4; ++m) { const int row = row0 + ai * HALF + m * 16; const float rs = tab[(u.i & 1) * BM + ai * HALF + wr * 64 + m * 16 + fr] * sc; const int s = row & 16383;
                    const f32x4 c0 = *(const f32x4*)(ropeC + (size_t)s * 32 + 8 * fq), c1 = *(const f32x4*)(ropeC + (size_t)s * 32 + 8 * fq + 4);
                    const f32x4 s0 = *(const f32x4*)(ropeS + (size_t)s * 32 + 8 * fq), s1 = *(const f32x4*)(ropeS + (size_t)s * 32 + 8 * fq + 4);
                    const f32x4 x10 = acc[ai][0][m][0] * rs, x11 = acc[ai][0][m][1] * rs, x20 = acc[ai][1][m][0] * rs, x21 = acc[ai][1][m][1] * rs;
                    const f32x4 o10 = x10 * c0 - x20 * s0, o11 = x11 * c1 - x21 * s1, o20 = x20 * c0 + x10 * s0, o21 = x21 * c1 + x11 * s1;
                    bf16_t* p = dst + (size_t)row * 1024 + head * 64 + 8 * fq;
                    *(u32x4*)p = pack8(o10, o11); *(u32x4*)(p + 32) = pack8(o20, o21);
                    if (which == 1) { ks0 += o10; ks1 += o11; ks2 += o20; ks3 += o21; }
                    if (m & 1) asm volatile("" ::: "memory"); }
            if (which == 1) {
                float* km = kmean + ((size_t)((u.pm >> 6) * 16 + head) * 64 + (u.pm & 63)) * 64;
#pragma unroll
                for (int k = 0; k < 16; ++k) { float v = k < 4 ? ks0[k & 3] : k < 8 ? ks1[k & 3] : k < 12 ? ks2[k & 3] : ks3[k & 3];
                    v += __shfl_xor(v, 1); v += __shfl_xor(v, 2); v += __shfl_xor(v, 4); v += __shfl_xor(v, 8);
                    const int d = (k < 8 ? 0 : 32) + 8 * fq + (k & 7);
                    if (fr == 0) __hip_atomic_fetch_add(km + d, v * (1.0f / 256.0f), __ATOMIC_RELAXED, __HIP_MEMORY_SCOPE_AGENT); }
            }
        }
    }
};
template <class Epi, class Sched, bool ALIGN_EPI = false, bool SP2 = false>
__device__ __forceinline__ void gemm_phase(PG8_LAS unsigned char* lds, const Gemm g, const Sched& S, const Epi& E) {
    int tid_ = threadIdx.x; asm volatile("" : "+v"(tid_));
    const int tid = tid_, wid = __builtin_amdgcn_readfirstlane(tid >> 6), lane = tid & 63, wr = wid >> 2, wc = wid & 3, fr = lane & 15, fq = lane >> 4;
    const int K = g.K, nt = K / BK;
    unsigned voffA[2], voffB[2];
#pragma unroll
    for (int i = 0; i < 2; ++i) { int R, C; stage_rc(tid * 16 + i * 8192, R, C); const int Rb = Epi::PERM ? ((R & ~31) + perm32(R & 31)) : R;
        voffA[i] = (unsigned)(R * g.lda + C) * 2u; voffB[i] = (unsigned)(Rb * K + C) * 2u; }
    const size_t kstep = (size_t)(BK * 2);
    const size_t hstep = (size_t)HALF * K * 2;
    const size_t tstep = 2 * hstep; const size_t hstepA = (size_t)HALF * g.lda * 2, tstepA = 2 * hstepA;
    const unsigned ldsw = (unsigned)wid * 1024u;
    const int aoff = lds_byte(wr * 64 + fr, fq * 8), boff = lds_byte(wc * 32 + fr, fq * 8);
#define PG8_SA(b, h) (((b) * 2 + (h)) * HTB)
#define PG8_SB(b, h) ((4 + (b) * 2 + (h)) * HTB)
#define PG8_STAGE(bufoff, gbase, voff) do { _Pragma("unroll") for (int _i = 0; _i < 2; ++_i) \
        __builtin_amdgcn_global_load_lds((const unsigned*)((const char*)(gbase) + (voff)[_i]), (PG8_LAS unsigned*)(lds + (bufoff) + ldsw + _i * 8192), 16, 0, 0); } while (0)
#define PG8_LDA(dst, b, h) do { _Pragma("unroll") for (int m = 0; m < 4; ++m) _Pragma("unroll") for (int k = 0; k < 2; ++k) dst[m][k] = *(const PG8_LAS bf16x8*)(lds + PG8_SA(b, h) + aoff + m * 2048 + k * 1024); } while (0)
#define PG8_LDB(dst, b, h) do { _Pragma("unroll") for (int n = 0; n < 2; ++n) _Pragma("unroll") for (int k = 0; k < 2; ++k) dst[n][k] = *(const PG8_LAS bf16x8*)(lds + PG8_SB(b, h) + boff + n * 2048 + k * 1024); } while (0)
#define PG8_MMA(ai, bj, At, Bt) do { __builtin_amdgcn_s_setprio(1); _Pragma("unroll") for (int m = 0; m < 4; ++m) _Pragma("unroll") for (int n = 0; n < 2; ++n) _Pragma("unroll") for (int k = 0; k < 2; ++k) \
        acc[ai][bj][m][n] = __builtin_amdgcn_mfma_f32_16x16x32_bf16(Bt[n][k], At[m][k], acc[ai][bj][m][n], 0, 0, 0); __builtin_amdgcn_s_setprio(0); } while (0)
#define PG8_WAIT_V(n) asm volatile("s_waitcnt vmcnt(" #n ")" ::: "memory")
#define PG8_WAIT_L(n) asm volatile("s_waitcnt lgkmcnt(" #n ")" ::: "memory")
#define PG8_BAR __builtin_amdgcn_s_barrier()
#define PG8_SCHED __builtin_amdgcn_sched_barrier(0)
    Unit cur, nxt; int ui = 0;
    if (!S.next(0, cur)) return;
    f32x4 acc[2][2][4][2];
#pragma unroll
    for (int a = 0; a < 2; ++a)
#pragma unroll
        for (int b = 0; b < 2; ++b)
#pragma unroll
            for (int m = 0; m < 4; ++m)
#pragma unroll
                for (int n = 0; n < 2; ++n) acc[a][b][m][n] = (f32x4){0.f, 0.f, 0.f, 0.f};
    bf16x8 At[4][2], B0[2][2], B1[2][2];
    const char* cA = (const char*)g.A + (size_t)cur.pm * tstepA; const char* cB = (const char*)g.Bt + (size_t)cur.pn * tstep;
    if constexpr (SP2) {
        PG8_STAGE(PG8_SB(0, 0), cB, voffB); PG8_STAGE(PG8_SB(0, 1), cB + hstep, voffB); PG8_STAGE(PG8_SA(0, 0), cA, voffA); PG8_STAGE(PG8_SA(0, 1), cA + hstepA, voffA);
        S.a_ready(cur);
        if (wr == 1) PG8_BAR;
        PG8_WAIT_V(2); PG8_BAR;
        PG8_STAGE(PG8_SB(1, 0), cB + kstep, voffB); PG8_STAGE(PG8_SA(1, 0), cA + kstep, voffA); PG8_STAGE(PG8_SB(1, 1), cB + hstep + kstep, voffB);
        PG8_WAIT_V(6); PG8_BAR;
    } else {
        S.a_ready(cur);
        PG8_STAGE(PG8_SB(0, 0), cB, voffB); PG8_STAGE(PG8_SA(0, 0), cA, voffA); PG8_STAGE(PG8_SB(0, 1), cB + hstep, voffB); PG8_STAGE(PG8_SA(0, 1), cA + hstepA, voffA);
        if (wr == 1) PG8_BAR;
        PG8_WAIT_V(4); PG8_BAR;
        PG8_STAGE(PG8_SB(1, 0), cB + kstep, voffB); PG8_STAGE(PG8_SA(1, 0), cA + kstep, voffA); PG8_STAGE(PG8_SB(1, 1), cB + hstep + kstep, voffB);
        PG8_WAIT_V(6); PG8_BAR;
    }
    for (;;) {
        const bool has_next = S.next(ui + 1, nxt);
        const char* nA = has_next ? (const char*)g.A + (size_t)nxt.pm * tstepA : cA; const char* nB = has_next ? (const char*)g.Bt + (size_t)nxt.pn * tstep : cB;
        for (int t = 0; t < nt; t += 2) {
            const bool last = (t == nt - 2);
            const char* a1 = cA + (size_t)(t + 1) * kstep;
            const char* a2 = last ? nA : cA + (size_t)(t + 2) * kstep; const char* b2 = last ? nB : cB + (size_t)(t + 2) * kstep;
            const char* a3 = a2 + kstep; const char* b3 = b2 + kstep;
            if (last && has_next) S.a_ready(nxt);
            if constexpr (SP2) {
            PG8_LDB(B0, 0, 0); PG8_LDB(B1, 0, 1); PG8_SCHED; PG8_LDA(At, 0, 0); PG8_STAGE(PG8_SA(1, 1), a1 + hstepA, voffA);
            PG8_WAIT_V(8); PG8_WAIT_L(0); PG8_BAR; PG8_MMA(0, 0, At, B0); PG8_MMA(0, 1, At, B1); PG8_BAR; PG8_SCHED;
            PG8_LDA(At, 0, 1); PG8_STAGE(PG8_SB(0, 0), b2, voffB); PG8_STAGE(PG8_SB(0, 1), b2 + hstep, voffB); PG8_STAGE(PG8_SA(0, 0), a2, voffA);
            PG8_WAIT_V(8); PG8_WAIT_L(0); PG8_BAR; PG8_MMA(1, 0, At, B0); PG8_MMA(1, 1, At, B1); PG8_BAR; PG8_SCHED;
            PG8_LDB(B0, 1, 0); PG8_LDB(B1, 1, 1); PG8_SCHED; PG8_LDA(At, 1, 0); PG8_STAGE(PG8_SA(0, 1), a2 + hstepA, voffA);
            PG8_WAIT_V(8); PG8_WAIT_L(0); PG8_BAR; PG8_MMA(0, 0, At, B0); PG8_MMA(0, 1, At, B1); PG8_BAR; PG8_SCHED;
            PG8_LDA(At, 1, 1); PG8_STAGE(PG8_SB(1, 0), b3, voffB); PG8_STAGE(PG8_SB(1, 1), b3 + hstep, voffB); PG8_STAGE(PG8_SA(1, 0), a3, voffA);
            PG8_WAIT_V(8); PG8_WAIT_L(0); PG8_BAR; PG8_MMA(1, 0, At, B0); PG8_MMA(1, 1, At, B1); PG8_BAR; PG8_SCHED;
            } else {
            PG8_LDB(B0, 0, 0); PG8_SCHED; PG8_LDA(At, 0, 0); PG8_STAGE(PG8_SA(1, 1), a1 + hstepA, voffA);
            PG8_WAIT_L(8); PG8_BAR; PG8_WAIT_L(0); PG8_MMA(0, 0, At, B0); PG8_BAR; PG8_SCHED;
            PG8_LDB(B1, 0, 1); PG8_STAGE(PG8_SB(0, 0), b2, voffB);
            PG8_BAR; PG8_WAIT_L(0); PG8_MMA(0, 1, At, B1); PG8_BAR;
            PG8_LDA(At, 0, 1); PG8_STAGE(PG8_SA(0, 0), a2, voffA);
            PG8_BAR; PG8_WAIT_L(0); PG8_MMA(1, 0, At, B0); PG8_BAR; PG8_SCHED;
            PG8_STAGE(PG8_SB(0, 1), b2 + hstep, voffB);
            PG8_WAIT_V(6); PG8_BAR; PG8_MMA(1, 1, At, B1); PG8_BAR;
            PG8_LDB(B0, 1, 0); PG8_SCHED; PG8_LDA(At, 1, 0); PG8_STAGE(PG8_SA(0, 1), a2 + hstepA, voffA);
            PG8_WAIT_L(8); PG8_BAR; PG8_WAIT_L(0); PG8_MMA(0, 0, At, B0); PG8_BAR; PG8_SCHED;
            PG8_LDB(B1, 1, 1); PG8_STAGE(PG8_SB(1, 0), b3, voffB);
            PG8_BAR; PG8_WAIT_L(0); PG8_MMA(0, 1, At, B1); PG8_BAR;
            PG8_LDA(At, 1, 1); PG8_STAGE(PG8_SA(1, 0), a3, voffA);
            PG8_BAR; PG8_WAIT_L(0); PG8_MMA(1, 0, At, B0); PG8_BAR; PG8_SCHED;
            PG8_STAGE(PG8_SB(1, 1), b3 + hstep, voffB);
            PG8_WAIT_V(6); PG8_BAR; PG8_MMA(1, 1, At, B1); PG8_BAR;
            }
        }
        if constexpr (ALIGN_EPI) { if (wr == 0) PG8_BAR; }
        if constexpr (!Epi::AFTER_DRAIN) { E(acc, cur, wr, wc, fr, fq); S.done(cur); }
        if (!has_next) break;
#pragma unroll
        for (int a = 0; a < 2; ++a)
#pragma unroll
            for (int b = 0; b < 2; ++b)
#pragma unroll
                for (int m = 0; m < 4; ++m)
#pragma unroll
                    for (int n = 0; n < 2; ++n) acc[a][b][m][n] = (f32x4){0.f, 0.f, 0.f, 0.f};
        cur = nxt; cA = nA; cB = nB; ++ui;
        if constexpr (ALIGN_EPI) { if (wr == 1) PG8_BAR; }
    }
    PG8_WAIT_V(0);
    if constexpr (!ALIGN_EPI) { if (wr == 0) PG8_BAR; }
    PG8_BAR;
    if constexpr (Epi::AFTER_DRAIN) { E.fused(acc, cur, wr, wc, fr, fq, lds, wid, lane); S.done(cur); }
#undef PG8_SA
#undef PG8_SB
#undef PG8_STAGE
#undef PG8_LDA
#undef PG8_LDB
#undef PG8_MMA
#undef PG8_WAIT_V
#undef PG8_WAIT_L
#undef PG8_BAR
#undef PG8_SCHED
}
}

#include <hip/hip_bf16.h>
#include <cmath>
namespace attn_body {
using bf16=__hip_bfloat16;
using bf16x8=__attribute__((ext_vector_type(8)))short;
using s16x4=__attribute__((ext_vector_type(4)))short;
using f32x16=__attribute__((ext_vector_type(16)))float;
using u32x4=__attribute__((ext_vector_type(4)))unsigned;
constexpr int BATCH=2,NHEAD=16,SEQ=16384,D=64,DM=NHEAD*D;
constexpr int NW=8,QBLK=32,QB=QBLK*NW,KVBLK=64,NQB=SEQ/QB;
constexpr int ATTN_PITCH=DM, ATTN_UNIT_ROWS=QB;
__device__ __forceinline__ int crow(int r,int hi){return (r&3)+8*(r>>2)+4*hi;}
#define SBAR() __builtin_amdgcn_sched_barrier(0)
__device__ __forceinline__ void cmask(f32x16&p0,f32x16&p1,int jb,int qrel,int hi){
  const float NEG=-INFINITY; int kb=64*jb+4*hi;
  #pragma unroll
  for(int r=0;r<16;++r){int kv=kb+(r&3)+8*(r>>2); if(kv>qrel)p0[r]=NEG; if(kv+32>qrel)p1[r]=NEG;}
}

constexpr int NSLOT=3, NVSLOT=4, SLOTB=8192;
constexpr int LDS_K=0, LDS_V=NSLOT*SLOTB, LDS_WS=LDS_V+NVSLOT*SLOTB, LDS_OST=LDS_WS+NW*64*4, LDS_BYTES=LDS_OST+NW*4096;
constexpr float C2=0.125f*1.4426950408889634f;
__device__ __forceinline__ void glds16(const void*gsrc,unsigned lds_dst){unsigned keep;
  asm volatile("s_mov_b32 %0, m0\n\ts_mov_b32 m0, %2\n\ts_nop 0\n\tglobal_load_lds_dwordx4 %1, off\n\ts_mov_b32 m0, %0":"=&s"(keep):"v"(gsrc),"s"(lds_dst):"memory");}
__device__ __forceinline__ float max3f(float a,float b,float c){float r;asm("v_max3_f32 %0, %1, %2, %3":"=v"(r):"v"(a),"v"(b),"v"(c));return r;}
__device__ __forceinline__ float max2f(float a,float b){float r;asm("v_max_f32_e32 %0, %1, %2":"=v"(r):"v"(a),"v"(b));return r;}
__device__ __forceinline__ float fadd_s(float a,float b){float r;asm("v_add_f32_e32 %0, %1, %2":"=v"(r):"v"(a),"v"(b));return r;}
__device__ __forceinline__ float fsub_s(float a,float b){float r;asm("v_sub_f32_e32 %0, %1, %2":"=v"(r):"v"(a),"v"(b));return r;}
typedef float f32x2_t __attribute__((ext_vector_type(2))); typedef __bf16 bf16x2_t __attribute__((ext_vector_type(2)));
__device__ __forceinline__ unsigned cvtpk_s(float lo,float hi){f32x2_t v={lo,hi};bf16x2_t b=__builtin_convertvector(v,bf16x2_t);return __builtin_bit_cast(unsigned,b);}
#define WAIT_BAR(N) asm volatile("s_waitcnt vmcnt(" #N ") lgkmcnt(0)\n\ts_barrier":::"memory")

__device__ __forceinline__ void qkt(f32x16&p0,f32x16&p1,const char*Kslot,const bf16x8*qr,const f32x16&negm,int r32,int hi){
  const char*kb=Kslot+hi*1024+r32*16;
  #pragma unroll
  for(int d0=0;d0<4;++d0){
    const bf16x8 b0=*reinterpret_cast<const bf16x8*>(kb+d0*2048);
    const bf16x8 b1=*reinterpret_cast<const bf16x8*>(kb+d0*2048+512);
    if(d0==0){p0=__builtin_amdgcn_mfma_f32_32x32x16_bf16(b0,qr[0],negm,0,0,0);p1=__builtin_amdgcn_mfma_f32_32x32x16_bf16(b1,qr[0],negm,0,0,0);}
    else{p0=__builtin_amdgcn_mfma_f32_32x32x16_bf16(b0,qr[d0],p0,0,0,0);p1=__builtin_amdgcn_mfma_f32_32x32x16_bf16(b1,qr[d0],p1,0,0,0);}}
}
typedef __attribute__((address_space(3))) const char* lds_cptr;
typedef short v4i16_t __attribute__((ext_vector_type(4)));
__device__ __forceinline__ void kload8(bf16x8*kf,lds_cptr kp){
  kf[0]=*(const __attribute__((address_space(3))) bf16x8*)(kp);      kf[1]=*(const __attribute__((address_space(3))) bf16x8*)(kp+512);
  kf[2]=*(const __attribute__((address_space(3))) bf16x8*)(kp+2048); kf[3]=*(const __attribute__((address_space(3))) bf16x8*)(kp+2560);
  kf[4]=*(const __attribute__((address_space(3))) bf16x8*)(kp+4096); kf[5]=*(const __attribute__((address_space(3))) bf16x8*)(kp+4608);
  kf[6]=*(const __attribute__((address_space(3))) bf16x8*)(kp+6144); kf[7]=*(const __attribute__((address_space(3))) bf16x8*)(kp+6656);
}
__device__ __forceinline__ void kload2(bf16x8*kf,lds_cptr kp,int j){ kf[2*j]=*(const __attribute__((address_space(3))) bf16x8*)(kp+j*2048); kf[2*j+1]=*(const __attribute__((address_space(3))) bf16x8*)(kp+j*2048+512); }
__device__ __forceinline__ s16x4 vtr(lds_cptr p){ return __builtin_bit_cast(s16x4,__builtin_amdgcn_ds_read_tr16_b64_v4i16((__attribute__((address_space(3))) v4i16_t*)p)); }
__device__ __forceinline__ float rowmax(const f32x16&p0,const f32x16&p1){
  float a=max3f(p0[0],p0[1],p1[0]),b=max3f(p0[2],p0[3],p1[1]);a=max3f(a,p1[2],p1[3]);
  #pragma unroll
  for(int r=4;r<16;r+=4){a=max3f(a,p0[r],p0[r+1]);b=max3f(b,p0[r+2],p0[r+3]);a=max3f(a,p1[r],p1[r+1]);b=max3f(b,p1[r+2],p1[r+3]);}
  const float m=max2f(a,b);
  auto rr=__builtin_amdgcn_permlane32_swap(__float_as_uint(m),__float_as_uint(m),false,false);
  return max2f(__uint_as_float(rr[0]),__uint_as_float(rr[1]));
}
__device__ __forceinline__ void pv(f32x16*o,int vb,bf16x8 pa0,bf16x8 pa1,bf16x8 pa2,bf16x8 pa3){
  #pragma unroll
  for(int d0=0;d0<2;++d0){s16x4 lo[4],hi[4];
    #pragma unroll
    for(int ks=0;ks<4;++ks){
      asm volatile("ds_read_b64_tr_b16 %0,%1 offset:%c2":"=&v"(lo[ks]):"v"(vb),"i"(d0*4096+ks*1024):"memory");
      asm volatile("ds_read_b64_tr_b16 %0,%1 offset:%c2":"=&v"(hi[ks]):"v"(vb),"i"(d0*4096+ks*1024+512):"memory");}
    asm volatile("s_waitcnt lgkmcnt(0)":::"memory");SBAR();
    #define PK(k) (bf16x8){lo[k][0],lo[k][1],lo[k][2],lo[k][3],hi[k][0],hi[k][1],hi[k][2],hi[k][3]}
    o[d0]=__builtin_amdgcn_mfma_f32_32x32x16_bf16(pa0,PK(0),o[d0],0,0,0);
    o[d0]=__builtin_amdgcn_mfma_f32_32x32x16_bf16(pa1,PK(1),o[d0],0,0,0);
    o[d0]=__builtin_amdgcn_mfma_f32_32x32x16_bf16(pa2,PK(2),o[d0],0,0,0);
    o[d0]=__builtin_amdgcn_mfma_f32_32x32x16_bf16(pa3,PK(3),o[d0],0,0,0);
    #undef PK
  }
}

#ifndef ATTN_STORE16
#define ATTN_STORE16(p,v) (*(u32x4*)(p)=(v))
#endif

#define LAS_I __attribute__((address_space(3)))
template<int THRL,bool OWN> __device__ __forceinline__ void attn_unit(long kvrow0,int h,const LAS_I int*ent,long brow0,int oblk,const bf16*Q,const bf16*__restrict__ K,const bf16*__restrict__ V,bf16*PO,float*LSE,bf16*O,char*shm,bool pref,bool has_next,long nkvrow0,int nh,LAS_I int*ent_next,int e_next,bf16x8(&qr)[4]){
  int tid_=threadIdx.x; asm volatile("":"+v"(tid_)); const int tid=tid_,lane=tid&63,r32=lane&31,hi=lane>>5; const int wid=__builtin_amdgcn_readfirstlane(tid>>6);

  const bf16*Kh=K+kvrow0*DM+h*D,*Vh=V+kvrow0*DM+h*D;
  const unsigned lds0=(unsigned)(uintptr_t)shm;
  float*wsf=(float*)(shm+LDS_WS)+wid*64;
  const bf16*ksrc=Kh+(long)lane*DM+wid*8;
  const bf16*vsrc=Vh+(long)(16*(wid&3)+(lane>>2))*DM+(wid>>2)*32+(lane&3)*8;
  const unsigned kdst=lds0+LDS_K+wid*1024, vdst=lds0+LDS_V+wid*1024;
  #define DMA_K(t,slot) glds16(ksrc+(long)(t)*KVBLK*DM,(unsigned)__builtin_amdgcn_readfirstlane(kdst+(slot)))
  #define DMA_V(t,slot) glds16(vsrc+(long)(t)*KVBLK*DM,(unsigned)__builtin_amdgcn_readfirstlane(vdst+(slot)))
  const int vb0=(int)(lds0+LDS_V)+((lane>>4)&1)*32+(lane&3)*8+(4*hi+((lane&15)>>2))*64;
  const char*Kbase=shm+LDS_K; bf16x8 kf[8];
  const lds_cptr shm3=(lds_cptr)shm; const lds_cptr kp0=shm3+LDS_K+hi*1024+r32*16; const lds_cptr vp0=shm3+LDS_V+((lane>>4)&1)*32+(lane&3)*8+(4*hi+((lane&15)>>2))*64;
  const int NT=4;
  if(!pref){DMA_K(0,0);DMA_V(0,0);DMA_K(1,SLOTB);}
  if(!pref){ long qrow; if(OWN){qrow=kvrow0+wid*QBLK+r32;} else {int e_=ent[wid*QBLK+r32]; if(e_<0)e_=ent[0]; qrow=brow0+(e_>>2);}
    const bf16*Qw=Q+qrow*DM+h*D;
    #pragma unroll
    for(int d0=0;d0<4;++d0)qr[d0]=*reinterpret_cast<const bf16x8*>(&Qw[d0*16+hi*8]); }
  float mhat=0.f,l_reg=0.f;f32x16 o[2];o[0]=f32x16{};o[1]=f32x16{};f32x16 negm=f32x16{};asm volatile("":"+v"(negm));
  const int qrel=wid*QBLK+r32;
  #define CMASK(P0,P1,t) do{ if(OWN){int jb_=(t)-(NT-4); if(jb_>=0)cmask(P0,P1,jb_,qrel,hi);} }while(0)
  bool resc=false;
  #define START(P0,P1) do{ const float rm=rowmax(P0,P1); resc=false; \
    { const float dl=rm; mhat=fadd_s(mhat,dl); \
      _Pragma("unroll") for(int r=0;r<16;++r){P0[r]=fsub_s(P0[r],dl);P1[r]=fsub_s(P1[r],dl);} \
      _Pragma("unroll") for(int r=0;r<16;++r)negm[r]=-mhat; asm volatile("":"+v"(negm)); } \
    _Pragma("unroll") for(int r=0;r<16;++r)P0[r]=__builtin_amdgcn_exp2f(P0[r]); }while(0)
  #define RESC() do{ if(resc){ asm volatile("s_waitcnt lgkmcnt(0)":::"memory"); \
      _Pragma("unroll") for(int d_=0;d_<2;++d_) _Pragma("unroll") for(int r=0;r<16;++r)o[d_][r]*=wsf[crow(r,hi)]; } }while(0)
  f32x16 pA0,pA1,pB0,pB1;
  int sl_prev=0,sl_cur=0,sl_next=SLOTB;
  int vs_prev=0,vs_cur=0;
  #define ROT() do{sl_prev=sl_cur;sl_cur=sl_next;sl_next=(sl_next==(NSLOT-1)*SLOTB)?0:sl_next+SLOTB; vs_prev=vs_cur;vs_cur+=SLOTB;}while(0)
  DMA_K(2,2*SLOTB);
  if(!pref){WAIT_BAR(3);} else {DMA_V(0,0);WAIT_BAR(2);}
  qkt(pA0,pA1,Kbase,qr,negm,r32,hi);asm volatile("s_nop 15\n\ts_nop 7":"+v"(pA0),"+v"(pA1));CMASK(pA0,pA1,0);
  START(pA0,pA1);
  _Pragma("unroll") for(int r=0;r<16;++r)pA1[r]=__builtin_amdgcn_exp2f(pA1[r]);
  WAIT_BAR(0);
  DMA_K(3,0);DMA_V(1,SLOTB);DMA_V(2,2*SLOTB);DMA_V(3,3*SLOTB);
  ROT();
  kload8(kf,kp0+sl_cur);
  s16x4 vlo[8],vhi[8]; u32x4 pw0,pw1,pw2,pw3;
  #define PKW(P,B) cvtpk_s(P[B],P[B+1])
  #define PAF(k) __builtin_bit_cast(bf16x8,pw##k)
  #define VFR(i) (bf16x8){vlo[i][0],vlo[i][1],vlo[i][2],vlo[i][3],vhi[i][0],vhi[i][1],vhi[i][2],vhi[i][3]}
  #define PIN(x) asm volatile("":"+v"(x))
  #define MX3(a,b,c) __builtin_fmaxf(__builtin_fmaxf((a),(b)),(c))
  #define GAPA(MF,A0,A1,A2,A3,W0,W1,PW) do{ MF; sacc+=A0; sacc+=A1; sacc+=A2; sacc+=A3; PIN(sacc); W0; W1; PIN(PW); SBAR(); }while(0)
  #define EX(v) __builtin_amdgcn_exp2f(v)
  #define GAPB(MF,X,B) do{ MF; X[B]=EX(X[B]); X[B+1]=EX(X[B+1]); X[B+2]=EX(X[B+2]); X[B+3]=EX(X[B+3]); PIN(X); SBAR(); }while(0)
  #define VRD(i) do{ vlo[i]=vtr(vp_+(((i)>>2)*4096+((i)&3)*1024)); vhi[i]=vtr(vp_+(((i)>>2)*4096+((i)&3)*1024+512)); }while(0)
  #define KRD(G,j) do{ if(G){ kload2(kf,kp0+sl_next,j); SBAR(); } }while(0)
  #define STEP(C0,C1,P0,P1,t,GK,GV,GL) do{ SBAR(); \
    const lds_cptr vp_=vp0+vs_prev; \
    VRD(0); SBAR(); float sacc=(P0[0]+P0[1]); \
    GAPA(C0=__builtin_amdgcn_mfma_f32_32x32x16_bf16(kf[0],qr[0],negm,0,0,0), P0[2],P0[3],P0[4],P0[5],     pw0[0]=PKW(P0,0), pw0[1]=PKW(P0,2), pw0); \
    VRD(4); SBAR(); GAPA(C1=__builtin_amdgcn_mfma_f32_32x32x16_bf16(kf[1],qr[0],negm,0,0,0), P0[6],P0[7],P0[8],P0[9],     pw0[2]=PKW(P0,4), pw0[3]=PKW(P0,6), pw0); \
    VRD(1); SBAR(); GAPA(C0=__builtin_amdgcn_mfma_f32_32x32x16_bf16(kf[2],qr[1],C0,0,0,0),   P0[10],P0[11],P0[12],P0[13], pw1[0]=PKW(P0,8), pw1[1]=PKW(P0,10), pw1); \
    VRD(5); SBAR(); GAPA(C1=__builtin_amdgcn_mfma_f32_32x32x16_bf16(kf[3],qr[1],C1,0,0,0),   P0[14],P0[15],P1[0],P1[1],   pw1[2]=PKW(P0,12),pw1[3]=PKW(P0,14), pw1); \
    VRD(2); SBAR(); GAPA(C0=__builtin_amdgcn_mfma_f32_32x32x16_bf16(kf[4],qr[2],C0,0,0,0),   P1[2],P1[3],P1[4],P1[5],     pw2[0]=PKW(P1,0), pw2[1]=PKW(P1,2), pw2); \
    VRD(6); SBAR(); GAPA(C1=__builtin_amdgcn_mfma_f32_32x32x16_bf16(kf[5],qr[2],C1,0,0,0),   P1[6],P1[7],P1[8],P1[9],     pw2[2]=PKW(P1,4), pw2[3]=PKW(P1,6), pw2); \
    VRD(3); SBAR(); GAPA(C0=__builtin_amdgcn_mfma_f32_32x32x16_bf16(kf[6],qr[3],C0,0,0,0),   P1[10],P1[11],P1[12],P1[13], pw3[0]=PKW(P1,8), pw3[1]=PKW(P1,10), pw3); \
    VRD(7); SBAR(); GAPA(C1=__builtin_amdgcn_mfma_f32_32x32x16_bf16(kf[7],qr[3],C1,0,0,0),   P1[14],P1[15],0.f,0.f,       pw3[2]=PKW(P1,12),pw3[3]=PKW(P1,14), pw3); \
    l_reg+=sacc; \
    if(GK){DMA_K((t)+3,sl_cur);} if(GV){DMA_V((t)+1,sl_next);} \
    CMASK(C0,C1,t); \
    { float a=MX3(C0[0],C0[1],C1[0]),b=MX3(C0[2],C0[3],C1[1]); a=MX3(a,C1[2],C1[3]); \
      _Pragma("unroll") for(int r=4;r<16;r+=4){a=MX3(a,C0[r],C0[r+1]);b=MX3(b,C0[r+2],C0[r+3]);a=MX3(a,C1[r],C1[r+1]);b=MX3(b,C1[r+2],C1[r+3]);} \
      float rm=__builtin_fmaxf(a,b); { auto rr=__builtin_amdgcn_permlane32_swap(__float_as_uint(rm),__float_as_uint(rm),false,false); rm=__builtin_fmaxf(__uint_as_float(rr[0]),__uint_as_float(rr[1])); } \
      resc=false; \
      if(__builtin_expect(__any(rm>(float)THRL),0)){ const float dl=__builtin_fmaxf(rm,0.f); mhat+=dl; \
        _Pragma("unroll") for(int r=0;r<16;++r){C0[r]-=dl;C1[r]-=dl;} \
        _Pragma("unroll") for(int r=0;r<16;++r)negm[r]=-mhat; asm volatile("":"+v"(negm)); \
        const float f=__builtin_amdgcn_exp2f(-dl); l_reg*=f; if(hi==0)wsf[r32]=f; resc=true; } } \
    SBAR(); \
    GAPB(o[0]=__builtin_amdgcn_mfma_f32_32x32x16_bf16(PAF(0),VFR(0),o[0],0,0,0), C0,0); \
    GAPB(o[1]=__builtin_amdgcn_mfma_f32_32x32x16_bf16(PAF(0),VFR(4),o[1],0,0,0), C0,4); \
    KRD(GL,0); GAPB(o[0]=__builtin_amdgcn_mfma_f32_32x32x16_bf16(PAF(1),VFR(1),o[0],0,0,0), C0,8); \
    KRD(GL,1); GAPB(o[1]=__builtin_amdgcn_mfma_f32_32x32x16_bf16(PAF(1),VFR(5),o[1],0,0,0), C0,12); \
    KRD(GL,2); GAPB(o[0]=__builtin_amdgcn_mfma_f32_32x32x16_bf16(PAF(2),VFR(2),o[0],0,0,0), C1,0); \
    KRD(GL,3); GAPB(o[1]=__builtin_amdgcn_mfma_f32_32x32x16_bf16(PAF(2),VFR(6),o[1],0,0,0), C1,4); \
    GAPB(o[0]=__builtin_amdgcn_mfma_f32_32x32x16_bf16(PAF(3),VFR(3),o[0],0,0,0), C1,8); \
    GAPB(o[1]=__builtin_amdgcn_mfma_f32_32x32x16_bf16(PAF(3),VFR(7),o[1],0,0,0), C1,12); \
    }while(0)
  int t=1;
  #undef CMASK
  #define CMASK(P0,P1,t) do{}while(0)
  for(;t+5<NT;t+=2){
    STEP(pB0,pB1,pA0,pA1,t,true,true,true);     WAIT_BAR(2); RESC(); ROT();
    STEP(pA0,pA1,pB0,pB1,t+1,true,true,true);   WAIT_BAR(2); RESC(); ROT();
  }
  #undef CMASK
  #define CMASK(P0,P1,t) do{ if(OWN){int jb_=(t)-(NT-4); if(jb_>=0)cmask(P0,P1,jb_,qrel,hi);} }while(0)
  #define ENDW(tt) do{ if((tt)+3<NT){WAIT_BAR(2);} else if((tt)+2<NT){WAIT_BAR(1);} else {WAIT_BAR(0);} }while(0)
  for(;t+1<NT;t+=2){
    STEP(pB0,pB1,pA0,pA1,t,false,false,(t+1<NT));       WAIT_BAR(2); RESC(); ROT();
    if(!OWN&&has_next&&tid<256)ent_next[tid]=e_next;
    STEP(pA0,pA1,pB0,pB1,t+1,false,false,(t+2<NT));     WAIT_BAR(0); RESC(); ROT();
  }
  if(has_next){ const bf16*nks=K+nkvrow0*DM+nh*D+(long)lane*DM+wid*8;
    glds16(nks,(unsigned)__builtin_amdgcn_readfirstlane(kdst)); glds16(nks+(long)KVBLK*DM,(unsigned)__builtin_amdgcn_readfirstlane(kdst+SLOTB)); }
  STEP(pB0,pB1,pA0,pA1,NT-1,false,false,false); RESC();
  if(has_next){ long qrow; if(OWN){qrow=nkvrow0+wid*QBLK+r32;} else {int e_=ent_next[wid*QBLK+r32]; if(e_<0)e_=ent_next[0]; qrow=brow0+(e_>>2);}
    const bf16*Qn=Q+qrow*DM+nh*D;
    #pragma unroll
    for(int d0=0;d0<4;++d0)qr[d0]=*reinterpret_cast<const bf16x8*>(&Qn[d0*16+hi*8]); }
  { float sacc=pB0[0]+pB0[1]; _Pragma("unroll") for(int r=2;r<16;++r)sacc+=pB0[r]; _Pragma("unroll") for(int r=0;r<16;++r)sacc+=pB1[r]; l_reg+=sacc;
    pw0=(u32x4){PKW(pB0,0),PKW(pB0,2),PKW(pB0,4),PKW(pB0,6)};pw1=(u32x4){PKW(pB0,8),PKW(pB0,10),PKW(pB0,12),PKW(pB0,14)};pw2=(u32x4){PKW(pB1,0),PKW(pB1,2),PKW(pB1,4),PKW(pB1,6)};pw3=(u32x4){PKW(pB1,8),PKW(pB1,10),PKW(pB1,12),PKW(pB1,14)};
    SBAR(); pv(o,vb0+vs_cur,PAF(0),PAF(1),PAF(2),PAF(3)); }
  #undef PKW
  #undef PAF
  #undef VFR
  #undef PIN
  #undef MX3
  #undef GAPA
  #undef GAPB
  #undef EX
  #undef VRD
  #undef KRD
  #undef STEP
  #undef ENDW
  {auto rr=__builtin_amdgcn_permlane32_swap(__float_as_uint(l_reg),__float_as_uint(l_reg),false,false);l_reg=__uint_as_float(rr[0])+__uint_as_float(rr[1]);}
  if(hi==0){wsf[32+r32]=l_reg; wsf[r32]=mhat+__builtin_amdgcn_logf(l_reg);} asm volatile("s_waitcnt lgkmcnt(0)":::"memory");
  float rli[16];
  #pragma unroll
  for(int r=0;r<16;++r)rli[r]=__builtin_amdgcn_rcpf(wsf[32+crow(r,hi)]);
  { bf16*stg=(bf16*)(shm+LDS_OST)+wid*2048;
    #pragma unroll
    for(int r=0;r<16;++r){const int orow=crow(r,hi);
      #pragma unroll
      for(int d0=0;d0<2;++d0)stg[orow*64+d0*32+r32]=__float2bfloat16(o[d0][r]*rli[r]);}
    asm volatile("s_waitcnt lgkmcnt(0)":::"memory");
    if(!OWN){
      #pragma unroll
      for(int i=0;i<4;++i){const int row=i*8+(lane>>3),ch=lane&7; const u32x4 v=*(const u32x4*)(stg+row*64+ch*8); const int e_=ent[wid*QBLK+row]; const float ls=wsf[row];
        if(e_>=0){ const size_t idx=((size_t)(e_>>2)*16+h)*3+(e_&3); *(u32x4*)(PO+idx*64+ch*8)=v; if(ch==0)LSE[idx]=ls; } }
    } else {
      const int nsel=oblk<3?oblk:3;
      #pragma unroll
      for(int i=0;i<4;++i){const int row=i*8+(lane>>3),ch=lane&7; const u32x4 v=*(const u32x4*)(stg+row*64+ch*8); const float ls=wsf[row];
        const size_t idx0=((size_t)(oblk*256+wid*QBLK+row)*16+h)*3;
        float lr[3]; u32x4 pv_[3]; float M=ls;
        #pragma unroll
        for(int r=0;r<3;++r){ lr[r]=-INFINITY; pv_[r]=(u32x4){0u,0u,0u,0u}; if(r<nsel){ lr[r]=LSE[idx0+r]; pv_[r]=*(const u32x4*)(PO+(idx0+r)*64+ch*8); } M=fmaxf(M,lr[r]); }
        const float w0=__builtin_amdgcn_exp2f(ls-M); float W=w0; float a[8];
        #pragma unroll
        for(int k=0;k<4;++k){ a[2*k]=w0*__uint_as_float(v[k]<<16); a[2*k+1]=w0*__uint_as_float(v[k]&0xffff0000u); }
        #pragma unroll
        for(int r=0;r<3;++r){ const float w=__builtin_amdgcn_exp2f(lr[r]-M); W+=w;
          #pragma unroll
          for(int k=0;k<4;++k){ a[2*k]+=w*__uint_as_float(pv_[r][k]<<16); a[2*k+1]+=w*__uint_as_float(pv_[r][k]&0xffff0000u); } }
        const float iw=1.0f/W; u32x4 ov;
        #pragma unroll
        for(int k=0;k<4;++k) ov[k]=cvtpk_s(a[2*k]*iw,a[2*k+1]*iw);
        *(u32x4*)(O+(kvrow0+wid*QBLK+row)*DM+h*D+ch*8)=ov; }
    } }
  asm volatile("s_waitcnt lgkmcnt(0)\n\ts_barrier":::"memory");
  #undef DMA_K
  #undef DMA_V
  #undef CMASK
  #undef START
  #undef RESC
  #undef ROT
}

#undef SBAR
#undef WAIT_BAR
#undef LAS_I
}
constexpr int NWAVES = 8, NTHREADS = 512;
constexpr int SEQ = 16384, DM_ = 1024, NH = 16, TOK = 2 * SEQ, DFF = 2816, NUP = 2 * DFF;
constexpr size_t MiB = 1u << 20;
constexpr size_t WS_CTL = 0;
constexpr size_t WS_SSQ = 1 * MiB;
constexpr size_t WS_KMEAN = 3 * MiB;
constexpr size_t WS_ROPE = 4 * MiB;
constexpr size_t WS_WIN = 8 * MiB, WS_WOUT = 14 * MiB, WS_WQKV = 16 * MiB, WS_WO = 22 * MiB, WS_WUP0 = 24 * MiB, WS_WUP1 = 35 * MiB;
constexpr size_t WS_WDN0 = 46 * MiB, WS_WDN1 = WS_WDN0 + 5 * MiB + MiB / 2;
constexpr size_t WS_XB = 58 * MiB;
constexpr size_t WS_BIG = 122 * MiB;
constexpr size_t WS_CV = WS_BIG + 64 * MiB, WS_Y1 = WS_BIG + 128 * MiB;
constexpr size_t WS_Q = WS_BIG, WS_K = WS_BIG + 64 * MiB, WS_V = WS_BIG + 128 * MiB, WS_PO = WS_BIG + 192 * MiB, WS_LSE = WS_BIG + 288 * MiB, WS_LIST = WS_BIG + 292 * MiB;
constexpr size_t WS_RAW = WS_BIG + 176 * MiB;
constexpr size_t WS_END = 478 * MiB;
constexpr int LISTH = 516096;
static_assert(WS_WDN1 + (size_t)1024 * DFF * 2 <= WS_XB && WS_XB + (size_t)TOK * 1024 * 2 <= WS_BIG && WS_BIG + (size_t)TOK * DFF * 2 <= WS_RAW && WS_RAW + (size_t)(TOK / 64) * 4 * NUP * 2 <= WS_END, "d_ws map");
static_assert(WS_LIST + (size_t)32 * LISTH * 4 <= WS_END && WS_PO + (size_t)SEQ * 16 * 3 * 64 * 2 <= WS_LSE && WS_LSE + (size_t)SEQ * 16 * 3 * 4 <= WS_LIST, "attention map");
constexpr int RING_BYTES = 131072, LDS_BYTES = 147456, MISC_OFF = RING_BYTES + 512;
constexpr size_t WS_BAR = 16384;
#define LAS __attribute__((address_space(3)))
typedef unsigned short bf16;
typedef unsigned v4u __attribute__((ext_vector_type(4)));
typedef float f32x4 __attribute__((ext_vector_type(4)));
__device__ __forceinline__ unsigned f2bf(float f) { unsigned u = __builtin_bit_cast(unsigned, f); return (u + 0x7fffu + ((u >> 16) & 1u)) >> 16; }
__device__ __forceinline__ unsigned pk2(float lo, float hi) { return f2bf(lo) | (f2bf(hi) << 16); }
__device__ __forceinline__ float bflo(unsigned w) { return __builtin_bit_cast(float, w << 16); }
__device__ __forceinline__ float bfhi(unsigned w) { return __builtin_bit_cast(float, w & 0xffff0000u); }
typedef float f32x2 __attribute__((ext_vector_type(2)));
__device__ __forceinline__ unsigned cvtpk(f32x2 v) { typedef __bf16 bf16x2_t __attribute__((ext_vector_type(2))); const bf16x2_t b = __builtin_convertvector(v, bf16x2_t); return __builtin_bit_cast(unsigned, b); }
__device__ __forceinline__ f32x2 unpk(unsigned w) { return (f32x2){bflo(w), bfhi(w)}; }
__device__ __forceinline__ float wave_sum(float v) {
#pragma unroll
    for (int o = 1; o < 64; o <<= 1) v += __shfl_xor(v, o);
    return v;
}
__device__ __forceinline__ void p0_item(const float* __restrict__ W, int K, int N, bf16* __restrict__ WT, int nrow0, int srccol0, const float* __restrict__ gain, LAS float* scr, int k0, int lane) {
    float wv[32];
#pragma unroll
    for (int i = 0; i < 32; ++i) { const int kk = 2 * i + (lane >> 5); wv[i] = W[(size_t)(k0 + kk) * N + srccol0 + (lane & 31)]; }
    if (gain) {
#pragma unroll
        for (int i = 0; i < 32; ++i) wv[i] *= gain[k0 + 2 * i + (lane >> 5)]; }
#pragma unroll
    for (int i = 0; i < 32; ++i) scr[(2 * i + (lane >> 5)) * 33 + (lane & 31)] = wv[i];
    asm volatile("s_waitcnt lgkmcnt(0)" ::: "memory");
    const int c = lane & 7;
#pragma unroll
    for (int j = 0; j < 4; ++j) { const int n = (lane >> 3) + 8 * j; const LAS float* s = scr + (8 * c) * 33 + n;
        v4u o; o.x = cvtpk((f32x2){s[0 * 33], s[1 * 33]}); o.y = cvtpk((f32x2){s[2 * 33], s[3 * 33]}); o.z = cvtpk((f32x2){s[4 * 33], s[5 * 33]}); o.w = cvtpk((f32x2){s[6 * 33], s[7 * 33]});
        *(v4u*)(WT + (size_t)(nrow0 + n) * K + k0 + 8 * c) = o; }
    asm volatile("s_waitcnt lgkmcnt(0)" ::: "memory");
}
__device__ __forceinline__ int src_in(int n) { if (n < 1024) return n; const int m = n - 1024, t = m >> 8, w = m & 255; return ((w >> 7) ? 2048 : 1024) + t * 128 + (w & 127); }
__device__ __forceinline__ int src_qkv(int n) { const int t = n >> 8; if (t >= 8) return n; const int w = n & 255, bj = w >> 7, wc = (w & 127) >> 5, dd = w & 31; return (t >> 2) * 1024 + ((t & 3) * 4 + wc) * 64 + bj * 32 + dd; }
__device__ __forceinline__ int src_up(int n) { const int t = n >> 8, w = n & 255; return (w >> 7) * DFF + t * 128 + (w & 127); }
__device__ const double ROPE_INV[32] = {1.00000000000000000000e+00, 7.49894209332455874417e-01, 5.62341325190349072827e-01, 4.21696503428582225581e-01, 3.16227766016837941176e-01, 2.37137370566165517349e-01, 1.77827941003892292526e-01, 1.33352143216332402753e-01,
    1.00000000000000005551e-01, 7.49894209332455791150e-02, 5.62341325190349114460e-02, 4.21696503428582239459e-02, 3.16227766016837913421e-02, 2.37137370566165538166e-02, 1.77827941003892292526e-02, 1.33352143216332406223e-02,
    1.00000000000000002082e-02, 7.49894209332455791150e-03, 5.62341325190349097113e-03, 4.21696503428582291501e-03, 3.16227766016837939442e-03, 2.37137370566165538166e-03, 1.77827941003892275179e-03, 1.33352143216332406223e-03,
    1.00000000000000002082e-03, 7.49894209332455856203e-04, 5.62341325190349097113e-04, 4.21696503428582237290e-04, 3.16227766016837939442e-04, 2.37137370566165538166e-04, 1.77827941003892269758e-04, 1.33352143216332395381e-04};
__device__ __forceinline__ void sincos_d(double a, float& sn, float& cs) {
    const double k = __builtin_rint(a * 0.63661977236758134308);
    double r = __builtin_fma(-k, 1.57079632673412561417e+00, a); r = __builtin_fma(-k, 6.07710050650619224932e-11, r);
    const double z = r * r;
    double ps = 1.0 / 6227020800.0;
    ps = __builtin_fma(ps, z, -1.0 / 39916800.0); ps = __builtin_fma(ps, z, 1.0 / 362880.0); ps = __builtin_fma(ps, z, -1.0 / 5040.0); ps = __builtin_fma(ps, z, 1.0 / 120.0); ps = __builtin_fma(ps, z, -1.0 / 6.0); ps = __builtin_fma(ps * z, r, r);
    double pc = -1.0 / 87178291200.0;
    pc = __builtin_fma(pc, z, 1.0 / 479001600.0); pc = __builtin_fma(pc, z, -1.0 / 3628800.0); pc = __builtin_fma(pc, z, 1.0 / 40320.0); pc = __builtin_fma(pc, z, -1.0 / 720.0); pc = __builtin_fma(pc, z, 1.0 / 24.0); pc = __builtin_fma(pc, z, -0.5); pc = __builtin_fma(pc, z, 1.0);
    const int q = (int)k & 3;
    const double s_ = (q & 1) ? pc : ps, c_ = (q & 1) ? ps : pc;
    sn = (float)((q & 2) ? -s_ : s_); cs = (float)((q == 1 || q == 2) ? -c_ : c_);
}
struct Args { const float* in[12]; float* out; unsigned char* ws; };
__device__ __forceinline__ void p0_prologue(const Args& A, unsigned char* ws, LAS unsigned char* lds, int gw, int NGW, int wave, int lane) {
    LAS float* scr = (LAS float*)(lds + wave * 16384);
    constexpr int I_IN = 16 * 96, I_OUT = 16 * 32, I_QKV = 16 * 96, I_O = 16 * 32, I_UP = 16 * 176, I_DN = 44 * 32;
    constexpr int NITEMS = I_IN + I_OUT + I_QKV + I_O + 2 * I_UP + 2 * I_DN;
    for (int it = gw; it < NITEMS; it += NGW) {
        int r = it;
        if (r < I_IN) { const int kb = r / 96, nb = r % 96; p0_item(A.in[2], 1024, 3072, (bf16*)(ws + WS_WIN), 32 * nb, src_in(32 * nb), A.in[1], scr, 64 * kb, lane); continue; } r -= I_IN;
        if (r < I_OUT) { const int kb = r / 32, nb = r % 32; p0_item(A.in[4], 1024, 1024, (bf16*)(ws + WS_WOUT), 32 * nb, 32 * nb, nullptr, scr, 64 * kb, lane); continue; } r -= I_OUT;
        if (r < I_QKV) { const int kb = r / 96, nb = r % 96; p0_item(A.in[5], 1024, 3072, (bf16*)(ws + WS_WQKV), 32 * nb, src_qkv(32 * nb), A.in[1] + 1024, scr, 64 * kb, lane); continue; } r -= I_QKV;
        if (r < I_O) { const int kb = r / 32, nb = r % 32; p0_item(A.in[6], 1024, 1024, (bf16*)(ws + WS_WO), 32 * nb, 32 * nb, nullptr, scr, 64 * kb, lane); continue; } r -= I_O;
        if (r < 2 * I_UP) { const int l = r / I_UP; r -= l * I_UP; const int kb = r / 176, nb = r % 176;
            p0_item(A.in[8] + (size_t)l * 1024 * NUP, 1024, NUP, (bf16*)(ws + (l ? WS_WUP1 : WS_WUP0)), 32 * nb, src_up(32 * nb), A.in[7] + l * 1024, scr, 64 * kb, lane); continue; } r -= 2 * I_UP;
        { const int l = r / I_DN; r -= l * I_DN; const int kb = r / 32, nb = r % 32;
            p0_item(A.in[10] + (size_t)l * DFF * 1024, DFF, 1024, (bf16*)(ws + (l ? WS_WDN1 : WS_WDN0)), 32 * nb, 32 * nb, nullptr, scr, 64 * kb, lane); }
    }
    { const float* x = A.in[0]; bf16* xb = (bf16*)(ws + WS_XB); float* ssq = (float*)(ws + WS_SSQ);
      for (int m0 = gw * 4; m0 < TOK; m0 += NGW * 4) { f32x4 v[4][4]; float sq[4];
#pragma unroll
          for (int q = 0; q < 4; ++q) { const f32x4* xr = (const f32x4*)(x + (size_t)(m0 + q) * 1024) + lane;
#pragma unroll
              for (int j = 0; j < 4; ++j) v[q][j] = xr[64 * j]; }
#pragma unroll
          for (int q = 0; q < 4; ++q) { float s_ = 0.f;
#pragma unroll
              for (int j = 0; j < 4; ++j) s_ += (v[q][j][0] * v[q][j][0] + v[q][j][1] * v[q][j][1]) + (v[q][j][2] * v[q][j][2] + v[q][j][3] * v[q][j][3]);
              sq[q] = wave_sum(s_); }
#pragma unroll
          for (int q = 0; q < 4; ++q) { unsigned long long* o8 = (unsigned long long*)(xb + (size_t)(m0 + q) * 1024) + lane;
#pragma unroll
              for (int j = 0; j < 4; ++j) o8[64 * j] = (unsigned long long)cvtpk((f32x2){v[q][j][0], v[q][j][1]}) | ((unsigned long long)cvtpk((f32x2){v[q][j][2], v[q][j][3]}) << 32);
              if (lane < 16) ssq[(size_t)(m0 + q) * 16 + lane] = lane == 0 ? sq[q] : 0.f; } } }
    { const int gt = gw * 64 + lane, NGT = NGW * 64;
      float* km = (float*)(ws + WS_KMEAN); for (int i = gt; i < 2 * 16 * 64 * 64; i += NGT) km[i] = 0.f;
      unsigned* ctl = (unsigned*)(ws + WS_CTL); for (int i = gt; i < 4096; i += NGT) ctl[i] = 0u;
      float* rc = (float*)(ws + WS_ROPE); float* rsn = rc + SEQ * 32;
      for (int i = gt; i < SEQ * 32; i += NGT) { const int s = i >> 5, f = i & 31; float sn, cs; sincos_d((double)s * ROPE_INV[f], sn, cs); rc[i] = cs; rsn[i] = sn; } }
}
__device__ __forceinline__ void ffn_fix_phase(bf16* __restrict__ ACT, const bf16* __restrict__ RAW, const float* __restrict__ wc  , int gtid, int ngt) {
    constexpr int NCH = DFF / 8;
    for (int task = gtid; task < (TOK / 64) * NCH; task += ngt) { const int run = task / NCH, c = (task % NCH) * 8;
        f32x2 wg[3][4], wu[3][4];
#pragma unroll
        for (int j = 0; j < 3; ++j)
#pragma unroll
            for (int k = 0; k < 4; ++k) { wg[j][k] = *(const f32x2*)(wc + j * NUP + c + 2 * k); wu[j][k] = *(const f32x2*)(wc + j * NUP + DFF + c + 2 * k); }
        v4u gA = {0u, 0u, 0u, 0u}, gB = gA, uA = gA, uB = gA;
        if ((run & 255) != 0) { const bf16* pp = RAW + ((size_t)(run - 1) * 4 + 2) * NUP + c; gA = *(const v4u*)pp; uA = *(const v4u*)(pp + DFF); gB = *(const v4u*)(pp + NUP); uB = *(const v4u*)(pp + NUP + DFF); }
        const bf16* cp = RAW + (size_t)run * 4 * NUP + c; const v4u g0 = *(const v4u*)cp, u0 = *(const v4u*)(cp + DFF), g1 = *(const v4u*)(cp + NUP), u1 = *(const v4u*)(cp + NUP + DFF);
        v4u o0, o1;
#pragma unroll
        for (int k = 0; k < 4; ++k) {
            const f32x2 ga = unpk(gA[k]), gb = unpk(gB[k]), gc0 = unpk(g0[k]), gc1 = unpk(g1[k]), ua = unpk(uA[k]), ub = unpk(uB[k]), uc0 = unpk(u0[k]), uc1 = unpk(u1[k]);
            const f32x2 gv0 = wg[0][k] * ga + wg[1][k] * gb + wg[2][k] * gc0, uv0 = wu[0][k] * ua + wu[1][k] * ub + wu[2][k] * uc0;
            const f32x2 gv1 = wg[0][k] * gb + wg[1][k] * gc0 + wg[2][k] * gc1, uv1 = wu[0][k] * ub + wu[1][k] * uc0 + wu[2][k] * uc1;
            f32x2 e0 = gv0 * -1.4426950408889634f, e1 = gv1 * -1.4426950408889634f;
            e0.x = __builtin_amdgcn_rcpf(1.0f + __builtin_amdgcn_exp2f(e0.x)); e0.y = __builtin_amdgcn_rcpf(1.0f + __builtin_amdgcn_exp2f(e0.y)); e1.x = __builtin_amdgcn_rcpf(1.0f + __builtin_amdgcn_exp2f(e1.x)); e1.y = __builtin_amdgcn_rcpf(1.0f + __builtin_amdgcn_exp2f(e1.y));
            o0[k] = cvtpk(gv0 * e0 * uv0); o1[k] = cvtpk(gv1 * e1 * uv1); }
        *(v4u*)(ACT + (size_t)(run * 64) * DFF + c) = o0; *(v4u*)(ACT + (size_t)(run * 64 + 1) * DFF + c) = o1;
    }
}
__device__ __forceinline__ int list_off(int j) { return j * SEQ - 128 * j * (j + 1); }
typedef short gbf16x8 __attribute__((ext_vector_type(8)));
typedef float gf32x16 __attribute__((ext_vector_type(16)));
__device__ __forceinline__ bool gate_better(float a, int ja, float b, int jb) { return a > b || (a == b && ja < jb); }
__device__ __forceinline__ void gate_unit_params(int u, int G, int& b, int& h, int& chunk) {
    b = u >> 9; h = (u >> 5) & 15; chunk = u & 31;
    if (G == 256) { const int k = u >> 8, base = ((u & 31) + 16 * (k >> 1)) & 31; chunk = (k & 1) ? 31 - base : base; }
}
__device__ __forceinline__ void gate_phase(const bf16* __restrict__ Q, const float* __restrict__ kmean, unsigned* cnt, int* list, LAS unsigned char* lds, int tid) {
    constexpr int KMS = 144; LAS unsigned char* kmh = lds; LAS unsigned char* kml = lds + 64 * KMS;
    LAS int* hist = (LAS int*)(lds + 20480); LAS int* gbase = (LAS int*)(lds + 20480 + 256);
    const int lane = tid & 63, r32 = lane & 31, hi = lane >> 5, wid = __builtin_amdgcn_readfirstlane(tid >> 6);
    const int krow = tid >> 3, kcol = (tid & 7) * 8, G = gridDim.x; constexpr int NU = 2 * 16 * 32;
    f32x4 pk0 = {0.f, 0.f, 0.f, 0.f}, pk1 = pk0; gbf16x8 pq[2][4];
#pragma unroll
    for (int ct = 0; ct < 2; ++ct)
#pragma unroll
        for (int ks = 0; ks < 4; ++ks) pq[ct][ks] = gbf16x8{};
#define GATE_LOAD(uu) do { int b_, h_, c_; gate_unit_params((uu), G, b_, h_, c_); const float* kb_ = kmean + (size_t)(b_ * 16 + h_) * 4096 + krow * 64 + kcol; pk0 = *(const f32x4*)kb_; pk1 = *(const f32x4*)(kb_ + 4); \
        if (2 * c_ + (wid >> 2) > 0) { _Pragma("unroll") for (int ct = 0; ct < 2; ++ct) { const bf16* qp_ = Q + ((size_t)b_ * SEQ + c_ * 512 + wid * 64 + ct * 32 + r32) * 1024 + h_ * 64 + 8 * hi; \
            _Pragma("unroll") for (int ks = 0; ks < 4; ++ks) pq[ct][ks] = *(const gbf16x8*)(qp_ + 16 * ks); } } } while (0)
    int u = blockIdx.x;
    if (u < NU) GATE_LOAD(u);
    for (; u < NU; u += G) { int b, h, chunk; gate_unit_params(u, G, b, h, chunk);
        const f32x4 ck0 = pk0, ck1 = pk1; gbf16x8 cq[2][4];
#pragma unroll
        for (int ct = 0; ct < 2; ++ct)
#pragma unroll
            for (int ks = 0; ks < 4; ++ks) cq[ct][ks] = pq[ct][ks];
        __syncthreads();
        { v4u wh, wl;
#pragma unroll
          for (int k = 0; k < 4; ++k) { const f32x2 x = k < 2 ? (f32x2){ck0[2 * k], ck0[2 * k + 1]} : (f32x2){ck1[2 * k - 4], ck1[2 * k - 3]}; const unsigned w = cvtpk(x); wh[k] = w; wl[k] = cvtpk(x - unpk(w)); }
          *(LAS v4u*)(kmh + krow * KMS + kcol * 2) = wh; *(LAS v4u*)(kml + krow * KMS + kcol * 2) = wl; }
        if (tid < 64) hist[tid] = 0;
        __syncthreads();
        if (u + G < NU) GATE_LOAD(u + G);
        const int own = 2 * chunk + (wid >> 2);
        const int nsel = own < 3 ? own : 3;
        int si[2][3], sp[2][3];
#pragma unroll
        for (int ct = 0; ct < 2; ++ct)
#pragma unroll
            for (int r = 0; r < 3; ++r) { si[ct][r] = 0; sp[ct][r] = 0; }
        if (own > 0) {
            gbf16x8 ah[2][4], al[2][4];
#pragma unroll
            for (int jt = 0; jt < 2; ++jt)
#pragma unroll
                for (int ks = 0; ks < 4; ++ks) { const int off = (32 * jt + r32) * KMS + (16 * ks + 8 * hi) * 2; ah[jt][ks] = *(const LAS gbf16x8*)(kmh + off); al[jt][ks] = *(const LAS gbf16x8*)(kml + off); }
#pragma unroll
            for (int ct = 0; ct < 2; ++ct) {
                gbf16x8 qf[4];
#pragma unroll
                for (int ks = 0; ks < 4; ++ks) qf[ks] = cq[ct][ks];
                gf32x16 acc[2];
#pragma unroll
                for (int jt = 0; jt < 2; ++jt) { acc[jt] = gf32x16{};
#pragma unroll
                    for (int ks = 0; ks < 4; ++ks) { acc[jt] = __builtin_amdgcn_mfma_f32_32x32x16_bf16(al[jt][ks], qf[ks], acc[jt], 0, 0, 0); acc[jt] = __builtin_amdgcn_mfma_f32_32x32x16_bf16(ah[jt][ks], qf[ks], acc[jt], 0, 0, 0); } }
                float v1 = -3.0e38f, v2 = -3.0e38f, v3 = -3.0e38f; int i1 = 0, i2 = 0, i3 = 0;
#pragma unroll
                for (int jt = 0; jt < 2; ++jt)
#pragma unroll
                    for (int r = 0; r < 16; ++r) { const int j = 32 * jt + (r & 3) + 8 * (r >> 2) + 4 * hi; const float g = j < own ? acc[jt][r] : -3.0e38f;
                        if (g > v1) { v3 = v2; i3 = i2; v2 = v1; i2 = i1; v1 = g; i1 = j; } else if (g > v2) { v3 = v2; i3 = i2; v2 = g; i2 = j; } else if (g > v3) { v3 = g; i3 = j; } }
                float a_[3], b_[3]; int ja[3], jb[3];
                { auto r1 = __builtin_amdgcn_permlane32_swap(__float_as_uint(v1), __float_as_uint(v1), false, false); a_[0] = __uint_as_float(r1[0]); b_[0] = __uint_as_float(r1[1]);
                  auto r2 = __builtin_amdgcn_permlane32_swap(__float_as_uint(v2), __float_as_uint(v2), false, false); a_[1] = __uint_as_float(r2[0]); b_[1] = __uint_as_float(r2[1]);
                  auto r3 = __builtin_amdgcn_permlane32_swap(__float_as_uint(v3), __float_as_uint(v3), false, false); a_[2] = __uint_as_float(r3[0]); b_[2] = __uint_as_float(r3[1]);
                  auto q1 = __builtin_amdgcn_permlane32_swap((unsigned)i1, (unsigned)i1, false, false); ja[0] = (int)q1[0]; jb[0] = (int)q1[1];
                  auto q2 = __builtin_amdgcn_permlane32_swap((unsigned)i2, (unsigned)i2, false, false); ja[1] = (int)q2[0]; jb[1] = (int)q2[1];
                  auto q3 = __builtin_amdgcn_permlane32_swap((unsigned)i3, (unsigned)i3, false, false); ja[2] = (int)q3[0]; jb[2] = (int)q3[1]; }
                int m_[3];
                {
                  float ca = a_[0], cb = b_[0]; int cja = ja[0], cjb = jb[0]; int pa = 0, pb = 0;
#pragma unroll
                  for (int r = 0; r < 3; ++r) { const bool ta = gate_better(ca, cja, cb, cjb); m_[r] = ta ? cja : cjb;
                      if (ta) { ++pa; ca = pa == 1 ? a_[1] : pa == 2 ? a_[2] : -3.3e38f; cja = pa == 1 ? ja[1] : pa == 2 ? ja[2] : 1 << 20; }
                      else    { ++pb; cb = pb == 1 ? b_[1] : pb == 2 ? b_[2] : -3.3e38f; cjb = pb == 1 ? jb[1] : pb == 2 ? jb[2] : 1 << 20; } } }
                si[ct][0] = m_[0]; si[ct][1] = m_[1]; si[ct][2] = m_[2];
                if (hi == 0) {
                    sp[ct][0] = __hip_atomic_fetch_add(hist + m_[0], 1, __ATOMIC_RELAXED, __HIP_MEMORY_SCOPE_WORKGROUP);
                    if (nsel > 1) sp[ct][1] = __hip_atomic_fetch_add(hist + m_[1], 1, __ATOMIC_RELAXED, __HIP_MEMORY_SCOPE_WORKGROUP);
                    if (nsel > 2) sp[ct][2] = __hip_atomic_fetch_add(hist + m_[2], 1, __ATOMIC_RELAXED, __HIP_MEMORY_SCOPE_WORKGROUP); }
            }
        }
        __syncthreads();
        if (tid < 64) { const int c = hist[tid]; gbase[tid] = c > 0 ? (int)__hip_atomic_fetch_add(cnt + (b * 16 + h) * 64 + tid, (unsigned)c, __ATOMIC_RELAXED, __HIP_MEMORY_SCOPE_AGENT) : 0; }
        __syncthreads();
        if (own > 0 && hi == 0) { int* lb = list + (size_t)(b * 16 + h) * LISTH;
#pragma unroll
            for (int ct = 0; ct < 2; ++ct) { const int t = chunk * 512 + wid * 64 + ct * 32 + r32;
                lb[list_off(si[ct][0]) + gbase[si[ct][0]] + sp[ct][0]] = (t << 2) | 0;
                if (nsel > 1) lb[list_off(si[ct][1]) + gbase[si[ct][1]] + sp[ct][1]] = (t << 2) | 1;
                if (nsel > 2) lb[list_off(si[ct][2]) + gbase[si[ct][2]] + sp[ct][2]] = (t << 2) | 2; } }
    }
}
constexpr int ATT_ENT_OFF = attn_body::LDS_BYTES, ATT_PFX_OFF = attn_body::LDS_BYTES + 2048;
__device__ __forceinline__ void attn_sel_phase(int b, const unsigned* cnt, const int* list, const attn_body::bf16* Q, const attn_body::bf16* K, const attn_body::bf16* V, attn_body::bf16* PO, float* LSE, unsigned char* ldsg, int tid) {
    LAS int* ent = (LAS int*)((LAS unsigned char*)ldsg + ATT_ENT_OFF); LAS int* pfx = (LAS int*)((LAS unsigned char*)ldsg + ATT_PFX_OFF);
    __syncthreads();
    {
        const int c0 = (int)cnt[b * 1024 + 2 * tid], c1 = (int)cnt[b * 1024 + 2 * tid + 1]; const int a0 = (c0 + 255) >> 8, a1 = (c1 + 255) >> 8;
        const int lane_ = tid & 63, wv_ = tid >> 6; int inc = a0 + a1;
#pragma unroll
        for (int o_ = 1; o_ < 64; o_ <<= 1) { const int v_ = __shfl_up(inc, o_); if (lane_ >= o_) inc += v_; }
        LAS int* wtot = pfx + 1024;
        if (lane_ == 63) wtot[wv_] = inc;
        __syncthreads();
        int off_ = 0;
#pragma unroll
        for (int w_ = 0; w_ < 8; ++w_) off_ += (w_ < wv_) ? wtot[w_] : 0;
        const int excl = off_ + inc - (a0 + a1);
        pfx[2 * tid] = excl + a0; pfx[2 * tid + 1] = excl + a0 + a1;
        __syncthreads();
    }
    const int total = pfx[1023];
#define SEL_INFO(gg, l_, k_, h_, j_, n_) do { int lo_ = 0, hi_ = 1023; while (lo_ < hi_) { const int mid_ = (lo_ + hi_) >> 1; if (pfx[mid_] > (gg)) hi_ = mid_; else lo_ = mid_ + 1; } \
        l_ = lo_; k_ = (gg) - (lo_ ? pfx[lo_ - 1] : 0); h_ = lo_ >> 6; j_ = lo_ & 63; n_ = (int)cnt[b * 1024 + lo_]; } while (0)
    int g = blockIdx.x;
    if (g < total) {
        LAS int* ent_cur = ent; LAS int* ent_nxt = ent + 256;
        int l, k, h, j, n; SEL_INFO(g, l, k, h, j, n);
        if (tid < 256) { const int e = k * 256 + tid; ent_cur[tid] = e < n ? list[(size_t)(b * 16 + h) * LISTH + list_off(j) + e] : -1; }
        __syncthreads();
        bool pref = false; attn_body::bf16x8 qr[4];
        for (;;) {
            const int gn = g + gridDim.x; const bool hn = gn < total; int ln = 0, kn = 0, h2 = 0, j2 = 0, nn = 0, e_next = -1;
            if (hn) { SEL_INFO(gn, ln, kn, h2, j2, nn); if (tid < 256) { const int e = kn * 256 + tid; if (e < nn) e_next = list[(size_t)(b * 16 + h2) * LISTH + list_off(j2) + e]; } }
            attn_body::attn_unit<8, false>((long)b * SEQ + j * 256, h, ent_cur, (long)b * SEQ, 0, Q, K, V, PO, LSE, nullptr, (char*)ldsg, pref, hn, (long)b * SEQ + j2 * 256, h2, ent_nxt, e_next, qr);
            if (!hn) break;
            { LAS int* t_ = ent_cur; ent_cur = ent_nxt; ent_nxt = t_; }
            g = gn; h = h2; j = j2; pref = true; (void)ln; (void)l;
        }
    }
#undef SEL_INFO
}
__device__ __forceinline__ void attn_own_phase(int b, const attn_body::bf16* Q, const attn_body::bf16* K, const attn_body::bf16* V, attn_body::bf16* PO, float* LSE, attn_body::bf16* O, unsigned char* ldsg) {
    __syncthreads();
    bool pref = false; attn_body::bf16x8 qr[4];
    for (int g = blockIdx.x; g < 16 * 64; g += gridDim.x) { const int h = g >> 6, o = 63 - (g & 63); const int gn = g + gridDim.x; const bool hn = gn < 16 * 64; const int h2 = gn >> 6, o2 = 63 - (gn & 63);
        attn_body::attn_unit<8, true>((long)b * SEQ + o * 256, h, nullptr, (long)b * SEQ, o, Q, K, V, PO, LSE, O, (char*)ldsg, pref, hn, (long)b * SEQ + o2 * 256, h2, nullptr, 0, qr); pref = true; }
}
__device__ __forceinline__ void final_norm_phase(float* out, const bf16* __restrict__ xb, const float* __restrict__ ssq, const float* __restrict__ gain, int gw, int NGW, int lane) {
    f32x4 g0 = ((const f32x4*)gain)[2 * lane], g1 = ((const f32x4*)gain)[2 * lane + 1], g2 = ((const f32x4*)gain)[128 + 2 * lane], g3 = ((const f32x4*)gain)[128 + 2 * lane + 1];
    for (int m0 = gw * 8; m0 < TOK; m0 += NGW * 8) { v4u v[8][2]; float rs[8];
#pragma unroll
        for (int q = 0; q < 8; ++q) { const v4u* xr = (const v4u*)(xb + (size_t)(m0 + q) * 1024) + lane; v[q][0] = xr[0]; v[q][1] = xr[64]; rs[q] = pg8::row_rstd(ssq, m0 + q); }
#pragma unroll
        for (int q = 0; q < 8; ++q) { f32x4* o = (f32x4*)(out + (size_t)(m0 + q) * 1024) + 2 * lane;
            o[0] = (f32x4){bflo(v[q][0].x), bfhi(v[q][0].x), bflo(v[q][0].y), bfhi(v[q][0].y)} * rs[q] * g0; o[1] = (f32x4){bflo(v[q][0].z), bfhi(v[q][0].z), bflo(v[q][0].w), bfhi(v[q][0].w)} * rs[q] * g1;
            o[128] = (f32x4){bflo(v[q][1].x), bfhi(v[q][1].x), bflo(v[q][1].y), bfhi(v[q][1].y)} * rs[q] * g2; o[129] = (f32x4){bflo(v[q][1].z), bfhi(v[q][1].z), bflo(v[q][1].w), bfhi(v[q][1].w)} * rs[q] * g3; } }
}
#define XB_TMO      128
#define XB_XCNT(j)  (256  + 64 * (j))
#define XB_XSUB(j)  (1280 + 64 * (j))
#define XB_XGEN(j)  (2304 + 64 * (j))
#define XB_TOP      3328
#define XB_TOPGEN   3392
#define XCD_BAR_WORDS 3456
#define XB_SPIN_CAP (1u << 18)

__device__ __forceinline__ unsigned xb_ld(unsigned* p)              { return __hip_atomic_load(p, __ATOMIC_RELAXED, __HIP_MEMORY_SCOPE_AGENT); }
__device__ __forceinline__ unsigned xb_add(unsigned* p, unsigned v) { return __hip_atomic_fetch_add(p, v, __ATOMIC_RELAXED, __HIP_MEMORY_SCOPE_AGENT); }
__device__ __forceinline__ unsigned xb_xcc_id() { return (unsigned)__builtin_amdgcn_s_getreg((3 << 11) | 20) & 0xFu; }
#define XB_SPIN(cond, bar) do { unsigned _sp = 0; while (cond) { __builtin_amdgcn_s_sleep(1); \
    if ((++_sp & 255u) == 0u) { if (xb_ld(&(bar)[XB_TMO])) break; if (_sp > XB_SPIN_CAP) { atomicAdd(&(bar)[XB_TMO], 1u); break; } } } } while (0)

struct XcdBarrier {
    unsigned* bar; unsigned x;
    volatile LAS unsigned* st;
};

__device__ __forceinline__ XcdBarrier xcd_barrier_post(unsigned* bar, volatile LAS unsigned* st) {
    XcdBarrier b; b.bar = bar; b.x = xb_xcc_id(); b.st = st;
    if (threadIdx.x == 0) (void)xb_add(&bar[XB_XCNT(b.x)], 1u);
    return b;
}
__device__ __forceinline__ void xcd_barrier_complete(unsigned* bar, unsigned x, unsigned& nloc, unsigned& nx) {
    const unsigned G = gridDim.x * gridDim.y * gridDim.z;
    unsigned sum, cnt, mine, sp = 0u;
    for (;;) {
        sum = 0u; cnt = 0u; mine = 0u;
#pragma unroll
        for (unsigned j = 0; j < 16; ++j) { const unsigned c = xb_ld(&bar[XB_XCNT(j)]); sum += c; cnt += (c > 0u) ? 1u : 0u; mine = (j == x) ? c : mine; }
        if (sum == G) break;
        __builtin_amdgcn_s_sleep(1);
        if ((++sp & 255u) == 0u) { if (xb_ld(&bar[XB_TMO])) break; if (sp > XB_SPIN_CAP) { atomicAdd(&bar[XB_TMO], 1u); break; } }
    }
    nloc = mine > 0u ? mine : 1u; nx = cnt > 0u ? cnt : 1u;
}

__device__ __forceinline__ void xcd_barrier(const XcdBarrier& b) {
    asm volatile("s_waitcnt vmcnt(0)" ::: "memory");
    __syncthreads();
    if (threadIdx.x == 0) {
        unsigned* bar = b.bar;
        __builtin_amdgcn_s_waitcnt(0);
        unsigned nloc = b.st[0], nx = b.st[1];
        if (nloc == 0u) { xcd_barrier_complete(bar, b.x, nloc, nx); b.st[0] = nloc; b.st[1] = nx; }
        const unsigned old = xb_add(&bar[XB_XSUB(b.x)], 1u);
        const unsigned gen = old / nloc;
        if (old + 1u == (gen + 1u) * nloc) {
            __builtin_amdgcn_fence(__ATOMIC_RELEASE, "agent");
            asm volatile("s_waitcnt vmcnt(0)" ::: "memory");
            const unsigned og = xb_add(&bar[XB_TOP], 1u);
            const unsigned tg = og / nx;
            if (og + 1u == (tg + 1u) * nx) xb_add(&bar[XB_TOPGEN], 1u);
            else XB_SPIN(xb_ld(&bar[XB_TOPGEN]) == tg, bar);
            __builtin_amdgcn_fence(__ATOMIC_ACQUIRE, "agent");
            xb_add(&bar[XB_XGEN(b.x)], 1u);
            asm volatile("s_waitcnt vmcnt(0)" ::: "memory");
        } else {
            XB_SPIN(xb_ld(&bar[XB_XGEN(b.x)]) == gen, bar);
            __builtin_amdgcn_fence(__ATOMIC_ACQUIRE, "agent");
            asm volatile("s_waitcnt vmcnt(0)" ::: "memory");
        }
    }
    __syncthreads();
}

#define PH_VARS unsigned char* ws = A.ws; asm volatile("" : "+s"(ws)); int tid = threadIdx.x; asm volatile("" : "+v"(tid)); const int lane = tid & 63, wave = __builtin_amdgcn_readfirstlane(tid >> 6); \
    const int G = gridDim.x, bx = blockIdx.x; const int gw = bx * NWAVES + wave, NGW = G * NWAVES, gtid = bx * NTHREADS + tid, NGT = G * NTHREADS; (void)lane; (void)gw; (void)NGW; (void)gtid; (void)NGT; \
    float* ssq = (float*)(ws + WS_SSQ); bf16* XB = (bf16*)(ws + WS_XB); float* out = A.out; bf16* ACT = (bf16*)(ws + WS_BIG); bf16* RAW = (bf16*)(ws + WS_RAW); (void)ssq; (void)XB; (void)out; (void)ACT; (void)RAW;
__global__ void __launch_bounds__(NTHREADS, 2) mk_fwd(Args A) {
    extern __shared__ __attribute__((aligned(16))) unsigned char lds[];
    cg::grid_group grid = cg::this_grid();
    LAS unsigned char* L = (LAS unsigned char*)lds;
    if (threadIdx.x < 64) ((LAS unsigned*)(L + RING_BYTES))[threadIdx.x * 4 + 0] = 0u, ((LAS unsigned*)(L + RING_BYTES))[threadIdx.x * 4 + 1] = 0u, ((LAS unsigned*)(L + RING_BYTES))[threadIdx.x * 4 + 2] = 0u, ((LAS unsigned*)(L + RING_BYTES))[threadIdx.x * 4 + 3] = 0u;
    __syncthreads();
    const XcdBarrier bar = xcd_barrier_post((unsigned*)(A.ws + WS_BAR), (volatile LAS unsigned*)(L + MISC_OFF));
#define GSYNC() xcd_barrier(bar)
#define RTAB ((LAS float*)(L + RING_BYTES + 1024))
    { PH_VARS p0_prologue(A, ws, L, gw, NGW, wave, lane); }
    if (gridDim.x == 0x7fffffffu) grid.sync();
    GSYNC();
    { PH_VARS pg8::Gemm g{XB, (const bf16*)(ws + WS_WIN) + (size_t)1024 * 1024, TOK, 2048, 1024, 1024}; pg8::StaticOrder S; S.init(TOK, 2048, G, bx, ssq, RTAB);
      pg8::EpiCV E{RTAB, (bf16*)(ws + WS_CV)};
      pg8::gemm_phase<pg8::EpiCV, pg8::StaticOrder, true, true>(L, g, S, E); }
    GSYNC();
    { PH_VARS pg8::Gemm g{XB, (const bf16*)(ws + WS_WIN), TOK, 1024, 1024, 1024}; pg8::StaticOrder S; S.init(TOK, 1024, G, bx, ssq, RTAB);
      pg8::EpiGate E{RTAB, (const bf16*)(ws + WS_CV), A.in[3], (bf16*)(ws + WS_Y1)};
      pg8::gemm_phase<pg8::EpiGate, pg8::StaticOrder, true, true>(L, g, S, E); }
    GSYNC();
    { PH_VARS pg8::Gemm g{(const bf16*)(ws + WS_Y1), (const bf16*)(ws + WS_WOUT), TOK, 1024, 1024, 1024}; pg8::StaticOrder S; S.init(TOK, 1024, G, bx);
      pg8::EpiRes<false> E{nullptr, XB, ssq};
      pg8::gemm_phase<pg8::EpiRes<false>, pg8::StaticOrder, true, true>(L, g, S, E); }
    GSYNC();
#pragma nounroll
    for (int layer_ = 0; layer_ < 2; ++layer_) {
        int layer = layer_; asm volatile("" : "+s"(layer));
        if (layer == 1) {
            { PH_VARS pg8::Gemm g{XB, (const bf16*)(ws + WS_WQKV), TOK, 3072, 1024, 1024}; pg8::StaticOrder S; S.init(TOK, 3072, G, bx, ssq, RTAB);
              pg8::EpiQkv E{RTAB, (bf16*)(ws + WS_Q), (bf16*)(ws + WS_K), (bf16*)(ws + WS_V), (const float*)(ws + WS_ROPE), (const float*)(ws + WS_ROPE) + SEQ * 32, (float*)(ws + WS_KMEAN)};
              pg8::gemm_phase<pg8::EpiQkv, pg8::StaticOrder, true, true>(L, g, S, E); }
            GSYNC();
            { PH_VARS gate_phase((const bf16*)(ws + WS_Q), (const float*)(ws + WS_KMEAN), (unsigned*)(ws + WS_CTL), (int*)(ws + WS_LIST), L, tid); }
#pragma nounroll
            for (int b_ = 0; b_ < 2; ++b_) {
                int b = b_; asm volatile("" : "+s"(b));
                GSYNC();
                { PH_VARS attn_sel_phase(b, (const unsigned*)(ws + WS_CTL), (const int*)(ws + WS_LIST), (const attn_body::bf16*)(ws + WS_Q), (const attn_body::bf16*)(ws + WS_K), (const attn_body::bf16*)(ws + WS_V),
                                 (attn_body::bf16*)(ws + WS_PO), (float*)(ws + WS_LSE), lds, tid); }
                GSYNC();
                { PH_VARS attn_own_phase(b, (const attn_body::bf16*)(ws + WS_Q), (const attn_body::bf16*)(ws + WS_K), (const attn_body::bf16*)(ws + WS_V), (attn_body::bf16*)(ws + WS_PO), (float*)(ws + WS_LSE), (attn_body::bf16*)(ws + WS_Q), lds); }
            }
            GSYNC();
            { PH_VARS pg8::Gemm g{(const bf16*)(ws + WS_Q), (const bf16*)(ws + WS_WO), TOK, 1024, 1024, 1024}; pg8::StaticOrder S; S.init(TOK, 1024, G, bx);
              pg8::EpiRes<false> E{nullptr, XB, ssq};
              pg8::gemm_phase<pg8::EpiRes<false>, pg8::StaticOrder, true, true>(L, g, S, E); }
            GSYNC();
        }
        { PH_VARS pg8::Gemm g{XB, (const bf16*)(ws + (layer ? WS_WUP1 : WS_WUP0)), TOK, NUP, 1024, 1024}; pg8::StaticOrder S; S.init(TOK, NUP, G, bx, ssq, RTAB);
          pg8::EpiUpAct E{RTAB, ACT, RAW, A.in[9] + (size_t)layer * 3 * NUP};
          pg8::gemm_phase<pg8::EpiUpAct, pg8::StaticOrder, true, true>(L, g, S, E); }
        GSYNC();
        { PH_VARS ffn_fix_phase(ACT, RAW, A.in[9] + (size_t)layer * 3 * NUP, gtid, NGT); }
        GSYNC();
        { PH_VARS pg8::Gemm g{ACT, (const bf16*)(ws + (layer ? WS_WDN1 : WS_WDN0)), TOK, 1024, DFF, DFF}; pg8::StaticOrder S; S.init(TOK, 1024, G, bx);
          pg8::EpiRes<false> E{nullptr, XB, ssq};
          pg8::gemm_phase<pg8::EpiRes<false>, pg8::StaticOrder, true, true>(L, g, S, E); }
        GSYNC();
    }
    { PH_VARS final_norm_phase(out, XB, ssq, A.in[11], gw, NGW, lane); }
}

extern "C" void kernel_launch(void* const* d_in, const int* in_sizes, int n_in, void* d_out, int out_size, void* d_ws, size_t ws_size, hipStream_t stream) {
    static int grid = 0;
    if (grid == 0) {
        if (n_in != 12 || in_sizes[0] != TOK * 1024 || out_size != TOK * 1024 || ws_size < WS_END) { fprintf(stderr, "kernel_launch: unexpected shapes / workspace (n_in %d, in0 %d, out %d, ws %zu, need %zu)\n", n_in, n_in > 0 ? in_sizes[0] : -1, out_size, ws_size, (size_t)WS_END); grid = -1; return; }
        int dev = 0, cus = 0, per_cu = 0;
        if (hipGetDevice(&dev) != hipSuccess || hipDeviceGetAttribute(&cus, hipDeviceAttributeMultiprocessorCount, dev) != hipSuccess) { grid = -1; return; }
        if (hipFuncSetAttribute((const void*)mk_fwd, hipFuncAttributeMaxDynamicSharedMemorySize, LDS_BYTES) != hipSuccess) { fprintf(stderr, "kernel_launch: hipFuncSetAttribute failed\n"); grid = -1; return; }
        if (hipOccupancyMaxActiveBlocksPerMultiprocessor(&per_cu, (const void*)mk_fwd, NTHREADS, LDS_BYTES) != hipSuccess || per_cu < 1) { fprintf(stderr, "kernel_launch: occupancy query says %d\n", per_cu); per_cu = 1; }
        (void)hipGetLastError();
        grid = cus;
    }
    if (grid < 0) return;
    Args a{};
    for (int i = 0; i < 12; ++i) a.in[i] = (const float*)d_in[i];
    a.out = (float*)d_out; a.ws = (unsigned char*)d_ws;
    if (hipMemsetAsync((char*)d_ws + WS_BAR, 0, XCD_BAR_WORDS * 4, stream) != hipSuccess) { fprintf(stderr, "kernel_launch: memset failed\n"); return; }
    void* args[] = {&a};
    hipError_t e = hipLaunchCooperativeKernel((const void*)mk_fwd, dim3(grid), dim3(NTHREADS), args, LDS_BYTES, stream);
    if (e != hipSuccess) fprintf(stderr, "kernel_launch: cooperative launch failed: %s (grid %d)\n", hipGetErrorString(e), grid);
}
```

```cpp
#include <hip/hip_runtime.h>
#include <hip/hip_cooperative_groups.h>
#include <cstdio>
#include <cstdint>
namespace cg = cooperative_groups;
namespace pg8 {
#define PG8_LAS __attribute__((address_space(3)))
typedef unsigned short bf16_t;
typedef short bf16x8 __attribute__((ext_vector_type(8)));
typedef float f32x4 __attribute__((ext_vector_type(4)));
typedef unsigned u32x4 __attribute__((ext_vector_type(4)));
constexpr int BM = 256, BK = 64, HALF = 128, HTB = HALF * BK * 2  , STAGE_BYTES = 8 * HTB, NXCD = 8, WGM = 8;

__host__ __device__ __forceinline__ int lds_byte(int r, int c) { const int st = (r >> 4) * 2 + (c >> 5), rr = r & 15, cc = c & 31, ob = rr * 64 + cc * 2; return st * 1024 + (ob ^ (((ob >> 9) & 1) << 5)); }
__host__ __device__ __forceinline__ void stage_rc(int b, int& R, int& C) { const int st = b / 1024, sb = b % 1024, swz = sb ^ (((sb >> 9) & 1) << 5); R = (st >> 1) * 16 + swz / 64; C = (st & 1) * 32 + (swz % 64) / 2; }
__host__ __device__ __forceinline__ int perm32(int rho) { const int n = rho >> 4, i = rho & 15; return 8 * (i >> 2) + 4 * n + (i & 3); }

struct Unit { int pm, pn, i; };
struct Gemm { const bf16_t* A; const bf16_t* Bt; int M, N, K, lda; };

struct StaticOrder {
    int nM, nN, nwg, G, c; const float* ssq; PG8_LAS float* tab;
    __host__ __device__ void init(int M, int N, int G_, int c_, const float* ssq_ = nullptr, PG8_LAS float* tab_ = nullptr) { nM = M / BM; nN = N / BM; nwg = nM * nN; G = G_; c = c_; ssq = ssq_; tab = tab_; }
    __host__ __device__ bool next(int i, Unit& u) const {
        const long L = (long)i * G + c; if (L >= nwg) return false;
        int wgid = (int)L; { const int q = nwg / NXCD, r = nwg % NXCD, xcd = wgid % NXCD, off = wgid / NXCD; wgid = (xcd < r ? xcd * (q + 1) : r * (q + 1) + (xcd - r) * q) + off; }
        const int nig = WGM * nN, gid = wgid / nig, fm = gid * WGM, gsz = (nM - fm) < WGM ? (nM - fm) : WGM;
        u.pm = fm + ((wgid % nig) % gsz); u.pn = (wgid % nig) / gsz; u.i = i; return true;
    }
    __device__ __forceinline__ void a_ready(const Unit& u) const {
        if (ssq) { int t_ = threadIdx.x; asm volatile("" : "+v"(t_)); const int t = t_, r = t >> 1, hf = t & 1; const f32x4* p = (const f32x4*)(ssq + (size_t)(u.pm * BM + r) * 16 + hf * 8); const f32x4 a = p[0], b = p[1];
            float s = ((a[0] + a[1]) + (a[2] + a[3])) + ((b[0] + b[1]) + (b[2] + b[3])); s += __shfl_xor(s, 1);
            if (hf == 0) tab[(u.i & 1) * BM + r] = __builtin_amdgcn_rsqf(s * (1.0f / 1024.0f) + 1e-6f); }
    }
    __device__ __forceinline__ void done(const Unit&) const {}
};

__device__ __forceinline__ unsigned cvt_pk_bf16(float lo, float hi) { unsigned r; asm volatile("v_cvt_pk_bf16_f32 %0, %1, %2" : "=v"(r) : "v"(lo), "v"(hi)); return r; }
typedef float f32x2 __attribute__((ext_vector_type(2)));
__device__ __forceinline__ u32x4 pack8(f32x4 v0, f32x4 v1) { u32x4 w; w.x = cvt_pk_bf16(v0[0], v0[1]); w.y = cvt_pk_bf16(v0[2], v0[3]); w.z = cvt_pk_bf16(v1[0], v1[1]); w.w = cvt_pk_bf16(v1[2], v1[3]); return w; }
__device__ __forceinline__ float row_rstd(const float* ssq, int row) {
    const f32x4* p = (const f32x4*)(ssq + (size_t)row * 16);
    const f32x4 a = p[0], b = p[1], c = p[2], d = p[3];
    const float s = (((a[0] + a[1]) + (a[2] + a[3])) + ((b[0] + b[1]) + (b[2] + b[3]))) + (((c[0] + c[1]) + (c[2] + c[3])) + ((d[0] + d[1]) + (d[2] + d[3])));
    return __builtin_amdgcn_rsqf(s * (1.0f / 1024.0f) + 1e-6f);
}
struct EpiCV {
    static constexpr bool PERM = true, AFTER_DRAIN = false;
    const PG8_LAS float* tab; bf16_t* CV;
    __device__ __forceinline__ void operator()(const f32x4 (&acc)[2][2][4][2], const Unit& u, int wr, int wc, int fr, int fq) const {
        const int row0 = u.pm * BM + wr * 64 + fr;
#pragma unroll
        for (int ai = 0; ai < 2; ++ai)
#pragma unroll
            for (int m = 0; m < 4; ++m) { const int row = row0 + ai * HALF + m * 16; const float rs = tab[(u.i & 1) * BM + ai * HALF + wr * 64 + m * 16 + fr]; const float r2 = rs * rs;
                *(u32x4*)(CV + (size_t)row * 1024 + u.pn * HALF + wc * 32 + 8 * fq) = pack8(acc[ai][0][m][0] * acc[ai][1][m][0] * r2, acc[ai][0][m][1] * acc[ai][1][m][1] * r2);
                if (m & 1) asm volatile("" ::: "memory"); }
    }
};
struct EpiGate {
    static constexpr bool PERM = true, AFTER_DRAIN = false;
    const PG8_LAS float* tab; const bf16_t* CV; const float* wconv; bf16_t* Y1;
    __device__ __forceinline__ void operator()(const f32x4 (&acc)[2][2][4][2], const Unit& u, int wr, int wc, int fr, int fq) const {
        const int row0 = u.pm * BM + wr * 64 + fr;
#pragma unroll
        for (int bj = 0; bj < 2; ++bj) { const int col = u.pn * 256 + bj * HALF + wc * 32 + 8 * fq;
            f32x4 w0[2], w1[2], w2[2];
#pragma unroll
            for (int n = 0; n < 2; ++n) { w0[n] = *(const f32x4*)(wconv + col + 4 * n); w1[n] = *(const f32x4*)(wconv + 1024 + col + 4 * n); w2[n] = *(const f32x4*)(wconv + 2048 + col + 4 * n); }
#pragma unroll
            for (int ai = 0; ai < 2; ++ai)
#pragma unroll
                for (int m = 0; m < 4; ++m) { const int row = row0 + ai * HALF + m * 16; const float rs = tab[(u.i & 1) * BM + ai * HALF + wr * 64 + m * 16 + fr]; const int sq = row & 16383;
                    const bf16_t* cp = CV + (size_t)row * 1024 + col;
                    const u32x4 c0 = *(const u32x4*)cp; u32x4 c1 = {0u, 0u, 0u, 0u}, c2 = c1;
                    if (sq >= 1) c1 = *(const u32x4*)(cp - 1024); if (sq >= 2) c2 = *(const u32x4*)(cp - 2048);
                    f32x4 y[2];
#pragma unroll
                    for (int n = 0; n < 2; ++n)
#pragma unroll
                        for (int i = 0; i < 4; ++i) { const int k = 2 * n + (i >> 1); const bool hi_ = i & 1;
                            const float x0 = __uint_as_float(hi_ ? (c0[k] & 0xffff0000u) : (c0[k] << 16)), x1 = __uint_as_float(hi_ ? (c1[k] & 0xffff0000u) : (c1[k] << 16)), x2 = __uint_as_float(hi_ ? (c2[k] & 0xffff0000u) : (c2[k] << 16));
                            y[n][i] = acc[ai][bj][m][n][i] * rs * (w0[n][i] * x2 + w1[n][i] * x1 + w2[n][i] * x0); }
                    *(u32x4*)(Y1 + (size_t)row * 1024 + col) = pack8(y[0], y[1]);
                    if (m == 3) asm volatile("" ::: "memory"); } }
    }
};
template <bool RESF32> struct EpiRes {
    static constexpr bool PERM = true, AFTER_DRAIN = false;
    const float* resf; bf16_t* xb; float* ssq;
    __device__ __forceinline__ void operator()(const f32x4 (&acc)[2][2][4][2], const Unit& u, int wr, int wc, int fr, int fq) const {
        const int row0 = u.pm * BM + wr * 64 + fr;
#pragma unroll
        for (int ai = 0; ai < 2; ++ai) {
            u32x4 pre[2][4][2];
            if (!RESF32) {
#pragma unroll
                for (int m = 0; m < 4; ++m)
#pragma unroll
                    for (int bj = 0; bj < 2; ++bj) pre[ai][m][bj] = *(const u32x4*)(xb + (size_t)(row0 + ai * HALF + m * 16) * 1024 + u.pn * 256 + bj * HALF + wc * 32 + 8 * fq);
            }
#pragma unroll
            for (int m = 0; m < 4; ++m) { const int row = row0 + ai * HALF + m * 16; float s = 0.f;
#pragma unroll
                for (int bj = 0; bj < 2; ++bj) { const size_t off = (size_t)row * 1024 + u.pn * 256 + bj * HALF + wc * 32 + 8 * fq;
                    f32x4 r0, r1;
                    if (RESF32) { r0 = *(const f32x4*)(resf + off); r1 = *(const f32x4*)(resf + off + 4); }
                    else { const u32x4 w = pre[ai][m][bj]; r0 = (f32x4){__uint_as_float(w.x << 16), __uint_as_float(w.x & 0xffff0000u), __uint_as_float(w.y << 16), __uint_as_float(w.y & 0xffff0000u)};
                           r1 = (f32x4){__uint_as_float(w.z << 16), __uint_as_float(w.z & 0xffff0000u), __uint_as_float(w.w << 16), __uint_as_float(w.w & 0xffff0000u)}; }
                    const f32x4 v0 = r0 + acc[ai][bj][m][0], v1 = r1 + acc[ai][bj][m][1];
                    *(u32x4*)(xb + off) = pack8(v0, v1);
                    s += ((v0[0] * v0[0] + v0[1] * v0[1]) + (v0[2] * v0[2] + v0[3] * v0[3])) + ((v1[0] * v1[0] + v1[1] * v1[1]) + (v1[2] * v1[2] + v1[3] * v1[3])); }
                s += __shfl_xor(s, 16); s += __shfl_xor(s, 32);
                if (fq == 0) ssq[(size_t)row * 16 + u.pn * 4 + wc] = s;
                if (RESF32 && (m & 1)) asm volatile("" ::: "memory"); }
            asm volatile("" ::: "memory"); }
    }
};
__device__ __forceinline__ float dpp_shr1(float v, float old) { return __int_as_float(__builtin_amdgcn_update_dpp(__float_as_int(old), __float_as_int(v), 0x111, 0xf, 0xf, false)); }
__device__ __forceinline__ float dpp_shr2(float v, float old) { return __int_as_float(__builtin_amdgcn_update_dpp(__float_as_int(old), __float_as_int(v), 0x112, 0xf, 0xf, false)); }
__device__ __forceinline__ float dpp_ror1(float v) { return __int_as_float(__builtin_amdgcn_update_dpp(0, __float_as_int(v), 0x121, 0xf, 0xf, false)); }
__device__ __forceinline__ float dpp_ror2(float v) { return __int_as_float(__builtin_amdgcn_update_dpp(0, __float_as_int(v), 0x122, 0xf, 0xf, false)); }
struct EpiUpAct {
    static constexpr bool PERM = true, AFTER_DRAIN = false;
    const PG8_LAS float* tab; bf16_t* ACT; bf16_t* RAW; const float* wconv;
    __device__ __forceinline__ void operator()(const f32x4 (&acc)[2][2][4][2], const Unit& u, int wr, int wc, int fr, int fq) const {
        typedef unsigned u32x2 __attribute__((ext_vector_type(2)));
        const int row0 = u.pm * BM + wr * 64 + fr; const int cb = u.pn * HALF + wc * 32 + 8 * fq;
        float rs[8];
#pragma unroll
        for (int q = 0; q < 8; ++q) rs[q] = tab[(u.i & 1) * BM + (q >> 2) * HALF + wr * 64 + (q & 3) * 16 + fr];
        u32x2 a0[8];
#pragma unroll
        for (int n = 0; n < 2; ++n) {
            f32x4 wg[3], wu[3];
#pragma unroll
            for (int j = 0; j < 3; ++j) { wg[j] = *(const f32x4*)(wconv + j * 5632 + cb + 4 * n); wu[j] = *(const f32x4*)(wconv + j * 5632 + 2816 + cb + 4 * n); }
#pragma unroll
            for (int ai = 0; ai < 2; ++ai)
#pragma unroll
                for (int m = 0; m < 4; ++m) { const int q = ai * 4 + m; const int row = row0 + ai * HALF + m * 16;
                    const f32x4 g = acc[ai][0][m][n] * rs[q], uu = acc[ai][1][m][n] * rs[q];
                    f32x4 pg = {0.f, 0.f, 0.f, 0.f}, pu = pg; if (m > 0) { pg = acc[ai][0][m - 1][n] * rs[q - 1]; pu = acc[ai][1][m - 1][n] * rs[q - 1]; }
                    f32x4 a;
#pragma unroll
                    for (int i = 0; i < 4; i += 2) {
                        typedef float f32x2v __attribute__((ext_vector_type(2)));
                        const f32x2v G = {g[i], g[i + 1]}, U = {uu[i], uu[i + 1]};
                        const f32x2v G1 = {dpp_shr1(g[i], dpp_ror1(pg[i])), dpp_shr1(g[i + 1], dpp_ror1(pg[i + 1]))}, G2 = {dpp_shr2(g[i], dpp_ror2(pg[i])), dpp_shr2(g[i + 1], dpp_ror2(pg[i + 1]))};
                        const f32x2v U1 = {dpp_shr1(uu[i], dpp_ror1(pu[i])), dpp_shr1(uu[i + 1], dpp_ror1(pu[i + 1]))}, U2 = {dpp_shr2(uu[i], dpp_ror2(pu[i])), dpp_shr2(uu[i + 1], dpp_ror2(pu[i + 1]))};
                        const f32x2v gc = (f32x2v){wg[0][i], wg[0][i + 1]} * G2 + (f32x2v){wg[1][i], wg[1][i + 1]} * G1 + (f32x2v){wg[2][i], wg[2][i + 1]} * G;
                        const f32x2v uc = (f32x2v){wu[0][i], wu[0][i + 1]} * U2 + (f32x2v){wu[1][i], wu[1][i + 1]} * U1 + (f32x2v){wu[2][i], wu[2][i + 1]} * U;
                        f32x2v e = gc * -1.4426950408889634f; e.x = __builtin_amdgcn_exp2f(e.x); e.y = __builtin_amdgcn_exp2f(e.y); e = e + 1.0f; e.x = __builtin_amdgcn_rcpf(e.x); e.y = __builtin_amdgcn_rcpf(e.y);
                        const f32x2v av = gc * e * uc; a[i] = av.x; a[i + 1] = av.y; }
                    const u32x2 pk = {cvt_pk_bf16(a[0], a[1]), cvt_pk_bf16(a[2], a[3])};
                    if (n == 0) a0[q] = pk;
                    else if (!(m == 0 && fr < 2)) *(u32x4*)(ACT + (size_t)row * 2816 + cb) = (u32x4){a0[q].x, a0[q].y, pk.x, pk.y};
                    if ((m == 0 && fr < 2) || (m == 3 && fr >= 14)) { const int slot = m == 0 ? fr : fr - 12; bf16_t* rp = RAW + ((size_t)(row >> 6) * 4 + slot) * 5632 + cb + 4 * n;
                        *(u32x2*)rp = (u32x2){cvt_pk_bf16(g[0], g[1]), cvt_pk_bf16(g[2], g[3])}; *(u32x2*)(rp + 2816) = (u32x2){cvt_pk_bf16(uu[0], uu[1]), cvt_pk_bf16(uu[2], uu[3])}; }
                    if (m & 1) asm volatile("" ::: "memory"); }
        }
    }
};
struct EpiQkv {
    static constexpr bool PERM = true, AFTER_DRAIN = false;
    const PG8_LAS float* tab; bf16_t* Q; bf16_t* Kb; bf16_t* V; const float* ropeC; const float* ropeS; float* kmean;
    __device__ __forceinline__ void operator()(const f32x4 (&acc)[2][2][4][2], const Unit& u, int wr, int wc, int fr, int fq) const {
        const int row0 = u.pm * BM + wr * 64 + fr; const int which = u.pn >> 2;
        if (which == 2) {
#pragma unroll
            for (int ai = 0; ai < 2; ++ai)
#pragma unroll
                for (int m = 0; m < 4; ++m) { const int row = row0 + ai * HALF + m * 16; const float rs = tab[(u.i & 1) * BM + ai * HALF + wr * 64 + m * 16 + fr];
#pragma unroll
                    for (int bj = 0; bj < 2; ++bj) *(u32x4*)(V + (size_t)row * 1024 + (u.pn - 8) * 256 + bj * HALF + wc * 32 + 8 * fq) = pack8(acc[ai][bj][m][0] * rs, acc[ai][bj][m][1] * rs);
                    if (m & 1) asm volatile("" ::: "memory"); }
        } else {
            bf16_t* dst = which == 0 ? Q : Kb; const float sc = which == 0 ? 0.125f * 1.4426950408889634f : 1.0f; const int head = (u.pn & 3) * 4 + wc;
            f32x4 ks0 = {0.f, 0.f, 0.f, 0.f}, ks1 = ks0, ks2 = ks0, ks3 = ks0;
#pragma unroll
            for (int ai = 0; ai < 2; ++ai)
#pragma unroll
                for (int m = 0; m < 4; ++m) { const int row = row0 + ai * HALF + m * 16; const float rs = tab[(u.i & 1) * BM + ai * HALF + wr * 64 + m * 16 + fr] * sc; const int s = row & 16383;
                    const f32x4 c0 = *(const f32x4*)(ropeC + (size_t)s * 32 + 8 * fq), c1 = *(const f32x4*)(ropeC + (size_t)s * 32 + 8 * fq + 4);
                    const f32x4 s0 = *(const f32x4*)(ropeS + (size_t)s * 32 + 8 * fq), s1 = *(const f32x4*)(ropeS + (size_t)s * 32 + 8 * fq + 4);
                    const f32x4 x10 = acc[ai][0][m][0] * rs, x11 = acc[ai][0][m][1] * rs, x20 = acc[ai][1][m][0] * rs, x21 = acc[ai][1][m][1] * rs;
                    const f32x4 o10 = x10 * c0 - x20 * s0, o11 = x11 * c1 - x21 * s1, o20 = x20 * c0 + x10 * s0, o21 = x21 * c1 + x11 * s1;
                    bf16_t* p = dst + (size_t)row * 1024 + head * 64 + 8 * fq;
                    *(u32x4*)p = pack8(o10, o11); *(u32x4*)(p + 32) = pack8(o20, o21);
                    if (which == 1) { ks0 += o10; ks1 += o11; ks2 += o20; ks3 += o21; }
                    if (m == 3) asm volatile("" ::: "memory"); }
            if (which == 1) {
                float* km = kmean + ((size_t)((u.pm >> 6) * 16 + head) * 64 + (u.pm & 63)) * 64;
#pragma unroll
                for (int k = 0; k < 16; ++k) { float v = k < 4 ? ks0[k & 3] : k < 8 ? ks1[k & 3] : k < 12 ? ks2[k & 3] : ks3[k & 3];
                    v += __shfl_xor(v, 1); v += __shfl_xor(v, 2); v += __shfl_xor(v, 4); v += __shfl_xor(v, 8);
                    const int d = (k < 8 ? 0 : 32) + 8 * fq + (k & 7);
                    if (fr == 0) __hip_atomic_fetch_add(km + d, v * (1.0f / 256.0f), __ATOMIC_RELAXED, __HIP_MEMORY_SCOPE_AGENT); }
            }
        }
    }
};
template <class Epi, class Sched, bool ALIGN_EPI = false, bool SP2 = false>
__device__ __forceinline__ void gemm_phase(PG8_LAS unsigned char* lds, const Gemm g, const Sched& S, const Epi& E) {
    int tid_ = threadIdx.x; asm volatile("" : "+v"(tid_));
    const int tid = tid_, wid = __builtin_amdgcn_readfirstlane(tid >> 6), lane = tid & 63, wr = wid >> 2, wc = wid & 3, fr = lane & 15, fq = lane >> 4;
    const int K = g.K, nt = K / BK;
    unsigned voffA[2], voffB[2];
#pragma unroll
    for (int i = 0; i < 2; ++i) { int R, C; stage_rc(tid * 16 + i * 8192, R, C); const int Rb = Epi::PERM ? ((R & ~31) + perm32(R & 31)) : R;
        voffA[i] = (unsigned)(R * g.lda + C) * 2u; voffB[i] = (unsigned)(Rb * K + C) * 2u; }
    const size_t kstep = (size_t)(BK * 2);
    const size_t hstep = (size_t)HALF * K * 2;
    const size_t tstep = 2 * hstep; const size_t hstepA = (size_t)HALF * g.lda * 2, tstepA = 2 * hstepA;
    const unsigned ldsw = (unsigned)wid * 1024u;
    const int aoff = lds_byte(wr * 64 + fr, fq * 8), boff = lds_byte(wc * 32 + fr, fq * 8);
#define PG8_SA(b, h) (((b) * 2 + (h)) * HTB)
#define PG8_SB(b, h) ((4 + (b) * 2 + (h)) * HTB)
#define PG8_STAGE(bufoff, gbase, voff) do { _Pragma("unroll") for (int _i = 0; _i < 2; ++_i) \
        __builtin_amdgcn_global_load_lds((const unsigned*)((const char*)(gbase) + (voff)[_i]), (PG8_LAS unsigned*)(lds + (bufoff) + ldsw + _i * 8192), 16, 0, 0); } while (0)
#define PG8_LDA(dst, b, h) do { _Pragma("unroll") for (int m = 0; m < 4; ++m) _Pragma("unroll") for (int k = 0; k < 2; ++k) dst[m][k] = *(const PG8_LAS bf16x8*)(lds + PG8_SA(b, h) + aoff + m * 2048 + k * 1024); } while (0)
#define PG8_LDB(dst, b, h) do { _Pragma("unroll") for (int n = 0; n < 2; ++n) _Pragma("unroll") for (int k = 0; k < 2; ++k) dst[n][k] = *(const PG8_LAS bf16x8*)(lds + PG8_SB(b, h) + boff + n * 2048 + k * 1024); } while (0)
#define PG8_MMA(ai, bj, At, Bt) do { __builtin_amdgcn_s_setprio(1); _Pragma("unroll") for (int m = 0; m < 4; ++m) _Pragma("unroll") for (int n = 0; n < 2; ++n) _Pragma("unroll") for (int k = 0; k < 2; ++k) \
        acc[ai][bj][m][n] = __builtin_amdgcn_mfma_f32_16x16x32_bf16(Bt[n][k], At[m][k], acc[ai][bj][m][n], 0, 0, 0); __builtin_amdgcn_s_setprio(0); } while (0)
#define PG8_WAIT_V(n) asm volatile("s_waitcnt vmcnt(" #n ")" ::: "memory")
#define PG8_WAIT_L(n) asm volatile("s_waitcnt lgkmcnt(" #n ")" ::: "memory")
#define PG8_BAR __builtin_amdgcn_s_barrier()
#define PG8_SCHED __builtin_amdgcn_sched_barrier(0)
    Unit cur, nxt; int ui = 0;
    if (!S.next(0, cur)) return;
    f32x4 acc[2][2][4][2];
#pragma unroll
    for (int a = 0; a < 2; ++a)
#pragma unroll
        for (int b = 0; b < 2; ++b)
#pragma unroll
            for (int m = 0; m < 4; ++m)
#pragma unroll
                for (int n = 0; n < 2; ++n) acc[a][b][m][n] = (f32x4){0.f, 0.f, 0.f, 0.f};
    bf16x8 At[4][2], B0[2][2], B1[2][2];
    const char* cA = (const char*)g.A + (size_t)cur.pm * tstepA; const char* cB = (const char*)g.Bt + (size_t)cur.pn * tstep;
    if constexpr (SP2) {
        PG8_STAGE(PG8_SB(0, 0), cB, voffB); PG8_STAGE(PG8_SB(0, 1), cB + hstep, voffB); PG8_STAGE(PG8_SA(0, 0), cA, voffA); PG8_STAGE(PG8_SA(0, 1), cA + hstepA, voffA);
        S.a_ready(cur);
        if (wr == 1) PG8_BAR;
        PG8_WAIT_V(2); PG8_BAR;
        PG8_STAGE(PG8_SB(1, 0), cB + kstep, voffB); PG8_STAGE(PG8_SA(1, 0), cA + kstep, voffA); PG8_STAGE(PG8_SB(1, 1), cB + hstep + kstep, voffB);
        PG8_WAIT_V(6); PG8_BAR;
    } else {
        S.a_ready(cur);
        PG8_STAGE(PG8_SB(0, 0), cB, voffB); PG8_STAGE(PG8_SA(0, 0), cA, voffA); PG8_STAGE(PG8_SB(0, 1), cB + hstep, voffB); PG8_STAGE(PG8_SA(0, 1), cA + hstepA, voffA);
        if (wr == 1) PG8_BAR;
        PG8_WAIT_V(4); PG8_BAR;
        PG8_STAGE(PG8_SB(1, 0), cB + kstep, voffB); PG8_STAGE(PG8_SA(1, 0), cA + kstep, voffA); PG8_STAGE(PG8_SB(1, 1), cB + hstep + kstep, voffB);
        PG8_WAIT_V(6); PG8_BAR;
    }
    for (;;) {
        const bool has_next = S.next(ui + 1, nxt);
        const char* nA = has_next ? (const char*)g.A + (size_t)nxt.pm * tstepA : cA; const char* nB = has_next ? (const char*)g.Bt + (size_t)nxt.pn * tstep : cB;
        for (int t = 0; t < nt; t += 2) {
            const bool last = (t == nt - 2);
            const char* a1 = cA + (size_t)(t + 1) * kstep;
            const char* a2 = last ? nA : cA + (size_t)(t + 2) * kstep; const char* b2 = last ? nB : cB + (size_t)(t + 2) * kstep;
            const char* a3 = a2 + kstep; const char* b3 = b2 + kstep;
            if (last && has_next) S.a_ready(nxt);
            if constexpr (SP2) {
            PG8_LDB(B0, 0, 0); PG8_LDB(B1, 0, 1); PG8_SCHED; PG8_LDA(At, 0, 0); PG8_STAGE(PG8_SA(1, 1), a1 + hstepA, voffA);
            PG8_WAIT_V(8); PG8_WAIT_L(0); PG8_BAR; PG8_MMA(0, 0, At, B0); PG8_MMA(0, 1, At, B1); PG8_BAR; PG8_SCHED;
            PG8_LDA(At, 0, 1); PG8_STAGE(PG8_SB(0, 0), b2, voffB); PG8_STAGE(PG8_SB(0, 1), b2 + hstep, voffB); PG8_STAGE(PG8_SA(0, 0), a2, voffA);
            PG8_WAIT_V(8); PG8_WAIT_L(0); PG8_BAR; PG8_MMA(1, 0, At, B0); PG8_MMA(1, 1, At, B1); PG8_BAR; PG8_SCHED;
            PG8_LDB(B0, 1, 0); PG8_LDB(B1, 1, 1); PG8_SCHED; PG8_LDA(At, 1, 0); PG8_STAGE(PG8_SA(0, 1), a2 + hstepA, voffA);
            PG8_WAIT_V(8); PG8_WAIT_L(0); PG8_BAR; PG8_MMA(0, 0, At, B0); PG8_MMA(0, 1, At, B1); PG8_BAR; PG8_SCHED;
            PG8_LDA(At, 1, 1); PG8_STAGE(PG8_SB(1, 0), b3, voffB); PG8_STAGE(PG8_SB(1, 1), b3 + hstep, voffB); PG8_STAGE(PG8_SA(1, 0), a3, voffA);
            PG8_WAIT_V(8); PG8_WAIT_L(0); PG8_BAR; PG8_MMA(1, 0, At, B0); PG8_MMA(1, 1, At, B1); PG8_BAR; PG8_SCHED;
            } else {
            PG8_LDB(B0, 0, 0); PG8_SCHED; PG8_LDA(At, 0, 0); PG8_STAGE(PG8_SA(1, 1), a1 + hstepA, voffA);
            PG8_WAIT_L(8); PG8_BAR; PG8_WAIT_L(0); PG8_MMA(0, 0, At, B0); PG8_BAR; PG8_SCHED;
            PG8_LDB(B1, 0, 1); PG8_STAGE(PG8_SB(0, 0), b2, voffB);
            PG8_BAR; PG8_WAIT_L(0); PG8_MMA(0, 1, At, B1); PG8_BAR;
            PG8_LDA(At, 0, 1); PG8_STAGE(PG8_SA(0, 0), a2, voffA);
            PG8_BAR; PG8_WAIT_L(0); PG8_MMA(1, 0, At, B0); PG8_BAR; PG8_SCHED;
            PG8_STAGE(PG8_SB(0, 1), b2 + hstep, voffB);
            PG8_WAIT_V(6); PG8_BAR; PG8_MMA(1, 1, At, B1); PG8_BAR;
            PG8_LDB(B0, 1, 0); PG8_SCHED; PG8_LDA(At, 1, 0); PG8_STAGE(PG8_SA(0, 1), a2 + hstepA, voffA);
            PG8_WAIT_L(8); PG8_BAR; PG8_WAIT_L(0); PG8_MMA(0, 0, At, B0); PG8_BAR; PG8_SCHED;
            PG8_LDB(B1, 1, 1); PG8_STAGE(PG8_SB(1, 0), b3, voffB);
            PG8_BAR; PG8_WAIT_L(0); PG8_MMA(0, 1, At, B1); PG8_BAR;
            PG8_LDA(At, 1, 1); PG8_STAGE(PG8_SA(1, 0), a3, voffA);
            PG8_BAR; PG8_WAIT_L(0); PG8_MMA(1, 0, At, B0); PG8_BAR; PG8_SCHED;
            PG8_STAGE(PG8_SB(1, 1), b3 + hstep, voffB);
            PG8_WAIT_V(6); PG8_BAR; PG8_MMA(1, 1, At, B1); PG8_BAR;
            }
        }
        if constexpr (ALIGN_EPI) { if (wr == 0) PG8_BAR; }
        if constexpr (!Epi::AFTER_DRAIN) { E(acc, cur, wr, wc, fr, fq); S.done(cur); }
        if (!has_next) break;
#pragma unroll
        for (int a = 0; a < 2; ++a)
#pragma unroll
            for (int b = 0; b < 2; ++b)
#pragma unroll
                for (int m = 0; m < 4; ++m)
#pragma unroll
                    for (int n = 0; n < 2; ++n) acc[a][b][m][n] = (f32x4){0.f, 0.f, 0.f, 0.f};
        cur = nxt; cA = nA; cB = nB; ++ui;
        if constexpr (ALIGN_EPI) { if (wr == 1) PG8_BAR; }
    }
    PG8_WAIT_V(0);
    if constexpr (!ALIGN_EPI) { if (wr == 0) PG8_BAR; }
    PG8_BAR;
    if constexpr (Epi::AFTER_DRAIN) { E.fused(acc, cur, wr, wc, fr, fq, lds, wid, lane); S.done(cur); }
#undef PG8_SA
#undef PG8_SB
#undef PG8_STAGE
#undef PG8_LDA
#undef PG8_LDB
#undef PG8_MMA
#undef PG8_WAIT_V
#undef PG8_WAIT_L
#undef PG8_BAR
#undef PG8_SCHED
}
}

#include <hip/hip_bf16.h>
#include <cmath>
namespace attn_body {
using bf16=__hip_bfloat16;
using bf16x8=__attribute__((ext_vector_type(8)))short;
using s16x4=__attribute__((ext_vector_type(4)))short;
using f32x16=__attribute__((ext_vector_type(16)))float;
using u32x4=__attribute__((ext_vector_type(4)))unsigned;
constexpr int BATCH=2,NHEAD=16,SEQ=16384,D=64,DM=NHEAD*D;
constexpr int NW=8,QBLK=32,QB=QBLK*NW,KVBLK=64,NQB=SEQ/QB;
constexpr int ATTN_PITCH=DM, ATTN_UNIT_ROWS=QB;
__device__ __forceinline__ int crow(int r,int hi){return (r&3)+8*(r>>2)+4*hi;}
#define SBAR() __builtin_amdgcn_sched_barrier(0)
__device__ __forceinline__ void cmask(f32x16&p0,f32x16&p1,int jb,int qrel,int hi){
  const float NEG=-INFINITY; int kb=64*jb+4*hi;
  #pragma unroll
  for(int r=0;r<16;++r){int kv=kb+(r&3)+8*(r>>2); if(kv>qrel)p0[r]=NEG; if(kv+32>qrel)p1[r]=NEG;}
}

constexpr int NSLOT=3, NVSLOT=4, SLOTB=8192;
constexpr int LDS_K=0, LDS_V=NSLOT*SLOTB, LDS_WS=LDS_V+NVSLOT*SLOTB, LDS_OST=LDS_WS+NW*64*4, LDS_BYTES=LDS_OST+NW*4096;
constexpr float C2=0.125f*1.4426950408889634f;
__device__ __forceinline__ void glds16(const void*gsrc,unsigned lds_dst){unsigned keep;
  asm volatile("s_mov_b32 %0, m0\n\ts_mov_b32 m0, %2\n\ts_nop 0\n\tglobal_load_lds_dwordx4 %1, off\n\ts_mov_b32 m0, %0":"=&s"(keep):"v"(gsrc),"s"(lds_dst):"memory");}
__device__ __forceinline__ float max3f(float a,float b,float c){float r;asm("v_max3_f32 %0, %1, %2, %3":"=v"(r):"v"(a),"v"(b),"v"(c));return r;}
__device__ __forceinline__ float max2f(float a,float b){float r;asm("v_max_f32_e32 %0, %1, %2":"=v"(r):"v"(a),"v"(b));return r;}
__device__ __forceinline__ float fadd_s(float a,float b){float r;asm("v_add_f32_e32 %0, %1, %2":"=v"(r):"v"(a),"v"(b));return r;}
__device__ __forceinline__ float fsub_s(float a,float b){float r;asm("v_sub_f32_e32 %0, %1, %2":"=v"(r):"v"(a),"v"(b));return r;}
typedef float f32x2_t __attribute__((ext_vector_type(2))); typedef __bf16 bf16x2_t __attribute__((ext_vector_type(2)));
__device__ __forceinline__ unsigned cvtpk_s(float lo,float hi){f32x2_t v={lo,hi};bf16x2_t b=__builtin_convertvector(v,bf16x2_t);return __builtin_bit_cast(unsigned,b);}
#define WAIT_BAR(N) asm volatile("s_waitcnt vmcnt(" #N ") lgkmcnt(0)\n\ts_barrier":::"memory")

__device__ __forceinline__ void qkt(f32x16&p0,f32x16&p1,const char*Kslot,const bf16x8*qr,const f32x16&negm,int r32,int hi){
  const char*kb=Kslot+hi*1024+r32*16;
  #pragma unroll
  for(int d0=0;d0<4;++d0){
    const bf16x8 b0=*reinterpret_cast<const bf16x8*>(kb+d0*2048);
    const bf16x8 b1=*reinterpret_cast<const bf16x8*>(kb+d0*2048+512);
    if(d0==0){p0=__builtin_amdgcn_mfma_f32_32x32x16_bf16(b0,qr[0],negm,0,0,0);p1=__builtin_amdgcn_mfma_f32_32x32x16_bf16(b1,qr[0],negm,0,0,0);}
    else{p0=__builtin_amdgcn_mfma_f32_32x32x16_bf16(b0,qr[d0],p0,0,0,0);p1=__builtin_amdgcn_mfma_f32_32x32x16_bf16(b1,qr[d0],p1,0,0,0);}}
}
typedef __attribute__((address_space(3))) const char* lds_cptr;
typedef short v4i16_t __attribute__((ext_vector_type(4)));
__device__ __forceinline__ void kload8(bf16x8*kf,lds_cptr kp){
  kf[0]=*(const __attribute__((address_space(3))) bf16x8*)(kp);      kf[1]=*(const __attribute__((address_space(3))) bf16x8*)(kp+512);
  kf[2]=*(const __attribute__((address_space(3))) bf16x8*)(kp+2048); kf[3]=*(const __attribute__((address_space(3))) bf16x8*)(kp+2560);
  kf[4]=*(const __attribute__((address_space(3))) bf16x8*)(kp+4096); kf[5]=*(const __attribute__((address_space(3))) bf16x8*)(kp+4608);
  kf[6]=*(const __attribute__((address_space(3))) bf16x8*)(kp+6144); kf[7]=*(const __attribute__((address_space(3))) bf16x8*)(kp+6656);
}
__device__ __forceinline__ void kload2(bf16x8*kf,lds_cptr kp,int j){ kf[2*j]=*(const __attribute__((address_space(3))) bf16x8*)(kp+j*2048); kf[2*j+1]=*(const __attribute__((address_space(3))) bf16x8*)(kp+j*2048+512); }
__device__ __forceinline__ s16x4 vtr(lds_cptr p){ return __builtin_bit_cast(s16x4,__builtin_amdgcn_ds_read_tr16_b64_v4i16((__attribute__((address_space(3))) v4i16_t*)p)); }
__device__ __forceinline__ float rowmax(const f32x16&p0,const f32x16&p1){
  float a=max3f(p0[0],p0[1],p1[0]),b=max3f(p0[2],p0[3],p1[1]);a=max3f(a,p1[2],p1[3]);
  #pragma unroll
  for(int r=4;r<16;r+=4){a=max3f(a,p0[r],p0[r+1]);b=max3f(b,p0[r+2],p0[r+3]);a=max3f(a,p1[r],p1[r+1]);b=max3f(b,p1[r+2],p1[r+3]);}
  const float m=max2f(a,b);
  auto rr=__builtin_amdgcn_permlane32_swap(__float_as_uint(m),__float_as_uint(m),false,false);
  return max2f(__uint_as_float(rr[0]),__uint_as_float(rr[1]));
}
__device__ __forceinline__ void pv(f32x16*o,int vb,bf16x8 pa0,bf16x8 pa1,bf16x8 pa2,bf16x8 pa3){
  #pragma unroll
  for(int d0=0;d0<2;++d0){s16x4 lo[4],hi[4];
    #pragma unroll
    for(int ks=0;ks<4;++ks){
      asm volatile("ds_read_b64_tr_b16 %0,%1 offset:%c2":"=&v"(lo[ks]):"v"(vb),"i"(d0*4096+ks*1024):"memory");
      asm volatile("ds_read_b64_tr_b16 %0,%1 offset:%c2":"=&v"(hi[ks]):"v"(vb),"i"(d0*4096+ks*1024+512):"memory");}
    asm volatile("s_waitcnt lgkmcnt(0)":::"memory");SBAR();
    #define PK(k) (bf16x8){lo[k][0],lo[k][1],lo[k][2],lo[k][3],hi[k][0],hi[k][1],hi[k][2],hi[k][3]}
    o[d0]=__builtin_amdgcn_mfma_f32_32x32x16_bf16(pa0,PK(0),o[d0],0,0,0);
    o[d0]=__builtin_amdgcn_mfma_f32_32x32x16_bf16(pa1,PK(1),o[d0],0,0,0);
    o[d0]=__builtin_amdgcn_mfma_f32_32x32x16_bf16(pa2,PK(2),o[d0],0,0,0);
    o[d0]=__builtin_amdgcn_mfma_f32_32x32x16_bf16(pa3,PK(3),o[d0],0,0,0);
    #undef PK
  }
}

#ifndef ATTN_STORE16
#define ATTN_STORE16(p,v) (*(u32x4*)(p)=(v))
#endif

#define LAS_I __attribute__((address_space(3)))
template<int THRL,bool OWN> __device__ __forceinline__ void attn_unit(long kvrow0,int h,const LAS_I int*ent,long brow0,int oblk,const bf16*Q,const bf16*__restrict__ K,const bf16*__restrict__ V,bf16*PO,float*LSE,bf16*O,char*shm,bool pref,bool has_next,long nkvrow0,int nh,LAS_I int*ent_next,int e_next,bf16x8(&qr)[4]){
  int tid_=threadIdx.x; asm volatile("":"+v"(tid_)); const int tid=tid_,lane=tid&63,r32=lane&31,hi=lane>>5; const int wid=__builtin_amdgcn_readfirstlane(tid>>6);

  const bf16*Kh=K+kvrow0*DM+h*D,*Vh=V+kvrow0*DM+h*D;
  const unsigned lds0=(unsigned)(uintptr_t)shm;
  float*wsf=(float*)(shm+LDS_WS)+wid*64;
  const bf16*ksrc=Kh+(long)lane*DM+wid*8;
  const bf16*vsrc=Vh+(long)(16*(wid&3)+(lane>>2))*DM+(wid>>2)*32+(lane&3)*8;
  const unsigned kdst=lds0+LDS_K+wid*1024, vdst=lds0+LDS_V+wid*1024;
  #define DMA_K(t,slot) glds16(ksrc+(long)(t)*KVBLK*DM,(unsigned)__builtin_amdgcn_readfirstlane(kdst+(slot)))
  #define DMA_V(t,slot) glds16(vsrc+(long)(t)*KVBLK*DM,(unsigned)__builtin_amdgcn_readfirstlane(vdst+(slot)))
  const int vb0=(int)(lds0+LDS_V)+((lane>>4)&1)*32+(lane&3)*8+(4*hi+((lane&15)>>2))*64;
  const char*Kbase=shm+LDS_K; bf16x8 kf[8];
  const lds_cptr shm3=(lds_cptr)shm; const lds_cptr kp0=shm3+LDS_K+hi*1024+r32*16; const lds_cptr vp0=shm3+LDS_V+((lane>>4)&1)*32+(lane&3)*8+(4*hi+((lane&15)>>2))*64;
  const int NT=4;
  if(!pref){DMA_K(0,0);DMA_V(0,0);DMA_K(1,SLOTB);}
  if(!pref){ long qrow; if(OWN){qrow=kvrow0+wid*QBLK+r32;} else {int e_=ent[wid*QBLK+r32]; if(e_<0)e_=ent[0]; qrow=brow0+(e_>>2);}
    const bf16*Qw=Q+qrow*DM+h*D;
    #pragma unroll
    for(int d0=0;d0<4;++d0)qr[d0]=*reinterpret_cast<const bf16x8*>(&Qw[d0*16+hi*8]); }
  float mhat=0.f,l_reg=0.f;f32x16 o[2];o[0]=f32x16{};o[1]=f32x16{};f32x16 negm=f32x16{};asm volatile("":"+v"(negm));
  const int qrel=wid*QBLK+r32;
  #define CMASK(P0,P1,t) do{ if(OWN){int jb_=(t)-(NT-4); if(jb_>=0)cmask(P0,P1,jb_,qrel,hi);} }while(0)
  bool resc=false;
  #define START(P0,P1) do{ const float rm=rowmax(P0,P1); resc=false; \
    { const float dl=rm; mhat=fadd_s(mhat,dl); \
      _Pragma("unroll") for(int r=0;r<16;++r){P0[r]=fsub_s(P0[r],dl);P1[r]=fsub_s(P1[r],dl);} \
      _Pragma("unroll") for(int r=0;r<16;++r)negm[r]=-mhat; asm volatile("":"+v"(negm)); } \
    _Pragma("unroll") for(int r=0;r<16;++r)P0[r]=__builtin_amdgcn_exp2f(P0[r]); }while(0)
  #define RESC() do{ if(resc){ asm volatile("s_waitcnt lgkmcnt(0)":::"memory"); \
      _Pragma("unroll") for(int d_=0;d_<2;++d_) _Pragma("unroll") for(int r=0;r<16;++r)o[d_][r]*=wsf[crow(r,hi)]; } }while(0)
  f32x16 pA0,pA1,pB0,pB1;
  int sl_prev=0,sl_cur=0,sl_next=SLOTB;
  int vs_prev=0,vs_cur=0;
  #define ROT() do{sl_prev=sl_cur;sl_cur=sl_next;sl_next=(sl_next==(NSLOT-1)*SLOTB)?0:sl_next+SLOTB; vs_prev=vs_cur;vs_cur+=SLOTB;}while(0)
  DMA_K(2,2*SLOTB);
  if(!pref){WAIT_BAR(3);} else {DMA_V(0,0);WAIT_BAR(2);}
  qkt(pA0,pA1,Kbase,qr,negm,r32,hi);asm volatile("s_nop 15\n\ts_nop 7":"+v"(pA0),"+v"(pA1));CMASK(pA0,pA1,0);
  START(pA0,pA1);
  _Pragma("unroll") for(int r=0;r<16;++r)pA1[r]=__builtin_amdgcn_exp2f(pA1[r]);
  WAIT_BAR(0);
  DMA_K(3,0);DMA_V(1,SLOTB);DMA_V(2,2*SLOTB);DMA_V(3,3*SLOTB);
  ROT();
  kload8(kf,kp0+sl_cur);
  s16x4 vlo[8],vhi[8]; u32x4 pw0,pw1,pw2,pw3;
  #define PKW(P,B) cvtpk_s(P[B],P[B+1])
  #define PAF(k) __builtin_bit_cast(bf16x8,pw##k)
  #define VFR(i) (bf16x8){vlo[i][0],vlo[i][1],vlo[i][2],vlo[i][3],vhi[i][0],vhi[i][1],vhi[i][2],vhi[i][3]}
  #define PIN(x) asm volatile("":"+v"(x))
  #define MX3(a,b,c) __builtin_fmaxf(__builtin_fmaxf((a),(b)),(c))
  #define GAPA(MF,A0,A1,A2,A3,W0,W1,PW) do{ MF; sacc+=A0; sacc+=A1; sacc+=A2; sacc+=A3; PIN(sacc); W0; W1; PIN(PW); SBAR(); }while(0)
  #define EX(v) __builtin_amdgcn_exp2f(v)
  #define GAPB(MF,X,B) do{ MF; X[B]=EX(X[B]); X[B+1]=EX(X[B+1]); X[B+2]=EX(X[B+2]); X[B+3]=EX(X[B+3]); PIN(X); SBAR(); }while(0)
  #define VRD(i) do{ vlo[i]=vtr(vp_+(((i)>>2)*4096+((i)&3)*1024)); vhi[i]=vtr(vp_+(((i)>>2)*4096+((i)&3)*1024+512)); }while(0)
  #define KRD(G,j) do{ if(G){ kload2(kf,kp0+sl_next,j); SBAR(); } }while(0)
  #define STEP(C0,C1,P0,P1,t,GK,GV,GL) do{ SBAR(); \
    const lds_cptr vp_=vp0+vs_prev; \
    VRD(0); SBAR(); float sacc=(P0[0]+P0[1]); \
    GAPA(C0=__builtin_amdgcn_mfma_f32_32x32x16_bf16(kf[0],qr[0],negm,0,0,0), P0[2],P0[3],P0[4],P0[5],     pw0[0]=PKW(P0,0), pw0[1]=PKW(P0,2), pw0); \
    VRD(4); SBAR(); GAPA(C1=__builtin_amdgcn_mfma_f32_32x32x16_bf16(kf[1],qr[0],negm,0,0,0), P0[6],P0[7],P0[8],P0[9],     pw0[2]=PKW(P0,4), pw0[3]=PKW(P0,6), pw0); \
    VRD(1); SBAR(); GAPA(C0=__builtin_amdgcn_mfma_f32_32x32x16_bf16(kf[2],qr[1],C0,0,0,0),   P0[10],P0[11],P0[12],P0[13], pw1[0]=PKW(P0,8), pw1[1]=PKW(P0,10), pw1); \
    VRD(5); SBAR(); GAPA(C1=__builtin_amdgcn_mfma_f32_32x32x16_bf16(kf[3],qr[1],C1,0,0,0),   P0[14],P0[15],P1[0],P1[1],   pw1[2]=PKW(P0,12),pw1[3]=PKW(P0,14), pw1); \
    VRD(2); SBAR(); GAPA(C0=__builtin_amdgcn_mfma_f32_32x32x16_bf16(kf[4],qr[2],C0,0,0,0),   P1[2],P1[3],P1[4],P1[5],     pw2[0]=PKW(P1,0), pw2[1]=PKW(P1,2), pw2); \
    VRD(6); SBAR(); GAPA(C1=__builtin_amdgcn_mfma_f32_32x32x16_bf16(kf[5],qr[2],C1,0,0,0),   P1[6],P1[7],P1[8],P1[9],     pw2[2]=PKW(P1,4), pw2[3]=PKW(P1,6), pw2); \
    VRD(3); SBAR(); GAPA(C0=__builtin_amdgcn_mfma_f32_32x32x16_bf16(kf[6],qr[3],C0,0,0,0),   P1[10],P1[11],P1[12],P1[13], pw3[0]=PKW(P1,8), pw3[1]=PKW(P1,10), pw3); \
    VRD(7); SBAR(); GAPA(C1=__builtin_amdgcn_mfma_f32_32x32x16_bf16(kf[7],qr[3],C1,0,0,0),   P1[14],P1[15],0.f,0.f,       pw3[2]=PKW(P1,12),pw3[3]=PKW(P1,14), pw3); \
    l_reg+=sacc; \
    if(GK){DMA_K((t)+3,sl_cur);} if(GV){DMA_V((t)+1,sl_next);} \
    CMASK(C0,C1,t); \
    { float a=MX3(C0[0],C0[1],C1[0]),b=MX3(C0[2],C0[3],C1[1]); a=MX3(a,C1[2],C1[3]); \
      _Pragma("unroll") for(int r=4;r<16;r+=4){a=MX3(a,C0[r],C0[r+1]);b=MX3(b,C0[r+2],C0[r+3]);a=MX3(a,C1[r],C1[r+1]);b=MX3(b,C1[r+2],C1[r+3]);} \
      float rm=__builtin_fmaxf(a,b); { auto rr=__builtin_amdgcn_permlane32_swap(__float_as_uint(rm),__float_as_uint(rm),false,false); rm=__builtin_fmaxf(__uint_as_float(rr[0]),__uint_as_float(rr[1])); } \
      resc=false; \
      if(__builtin_expect(__any(rm>(float)THRL),0)){ const float dl=__builtin_fmaxf(rm,0.f); mhat+=dl; \
        _Pragma("unroll") for(int r=0;r<16;++r){C0[r]-=dl;C1[r]-=dl;} \
        _Pragma("unroll") for(int r=0;r<16;++r)negm[r]=-mhat; asm volatile("":"+v"(negm)); \
        const float f=__builtin_amdgcn_exp2f(-dl); l_reg*=f; if(hi==0)wsf[r32]=f; resc=true; } } \
    SBAR(); \
    GAPB(o[0]=__builtin_amdgcn_mfma_f32_32x32x16_bf16(PAF(0),VFR(0),o[0],0,0,0), C0,0); \
    GAPB(o[1]=__builtin_amdgcn_mfma_f32_32x32x16_bf16(PAF(0),VFR(4),o[1],0,0,0), C0,4); \
    KRD(GL,0); GAPB(o[0]=__builtin_amdgcn_mfma_f32_32x32x16_bf16(PAF(1),VFR(1),o[0],0,0,0), C0,8); \
    KRD(GL,1); GAPB(o[1]=__builtin_amdgcn_mfma_f32_32x32x16_bf16(PAF(1),VFR(5),o[1],0,0,0), C0,12); \
    KRD(GL,2); GAPB(o[0]=__builtin_amdgcn_mfma_f32_32x32x16_bf16(PAF(2),VFR(2),o[0],0,0,0), C1,0); \
    KRD(GL,3); GAPB(o[1]=__builtin_amdgcn_mfma_f32_32x32x16_bf16(PAF(2),VFR(6),o[1],0,0,0), C1,4); \
    GAPB(o[0]=__builtin_amdgcn_mfma_f32_32x32x16_bf16(PAF(3),VFR(3),o[0],0,0,0), C1,8); \
    GAPB(o[1]=__builtin_amdgcn_mfma_f32_32x32x16_bf16(PAF(3),VFR(7),o[1],0,0,0), C1,12); \
    }while(0)
  int t=1;
  #undef CMASK
  #define CMASK(P0,P1,t) do{}while(0)
  for(;t+5<NT;t+=2){
    STEP(pB0,pB1,pA0,pA1,t,true,true,true);     WAIT_BAR(2); RESC(); ROT();
    STEP(pA0,pA1,pB0,pB1,t+1,true,true,true);   WAIT_BAR(2); RESC(); ROT();
  }
  #undef CMASK
  #define CMASK(P0,P1,t) do{ if(OWN){int jb_=(t)-(NT-4); if(jb_>=0)cmask(P0,P1,jb_,qrel,hi);} }while(0)
  #define ENDW(tt) do{ if((tt)+3<NT){WAIT_BAR(2);} else if((tt)+2<NT){WAIT_BAR(1);} else {WAIT_BAR(0);} }while(0)
  for(;t+1<NT;t+=2){
    STEP(pB0,pB1,pA0,pA1,t,false,false,(t+1<NT));       WAIT_BAR(2); RESC(); ROT();
    if(!OWN&&has_next&&tid<256)ent_next[tid]=e_next;
    STEP(pA0,pA1,pB0,pB1,t+1,false,false,(t+2<NT));     WAIT_BAR(0); RESC(); ROT();
  }
  if(has_next){ const bf16*nks=K+nkvrow0*DM+nh*D+(long)lane*DM+wid*8;
    glds16(nks,(unsigned)__builtin_amdgcn_readfirstlane(kdst)); glds16(nks+(long)KVBLK*DM,(unsigned)__builtin_amdgcn_readfirstlane(kdst+SLOTB)); }
  STEP(pB0,pB1,pA0,pA1,NT-1,false,false,false); RESC();
  if(has_next){ long qrow; if(OWN){qrow=nkvrow0+wid*QBLK+r32;} else {int e_=ent_next[wid*QBLK+r32]; if(e_<0)e_=ent_next[0]; qrow=brow0+(e_>>2);}
    const bf16*Qn=Q+qrow*DM+nh*D;
    #pragma unroll
    for(int d0=0;d0<4;++d0)qr[d0]=*reinterpret_cast<const bf16x8*>(&Qn[d0*16+hi*8]); }
  { float sacc=pB0[0]+pB0[1]; _Pragma("unroll") for(int r=2;r<16;++r)sacc+=pB0[r]; _Pragma("unroll") for(int r=0;r<16;++r)sacc+=pB1[r]; l_reg+=sacc;
    pw0=(u32x4){PKW(pB0,0),PKW(pB0,2),PKW(pB0,4),PKW(pB0,6)};pw1=(u32x4){PKW(pB0,8),PKW(pB0,10),PKW(pB0,12),PKW(pB0,14)};pw2=(u32x4){PKW(pB1,0),PKW(pB1,2),PKW(pB1,4),PKW(pB1,6)};pw3=(u32x4){PKW(pB1,8),PKW(pB1,10),PKW(pB1,12),PKW(pB1,14)};
    SBAR(); pv(o,vb0+vs_cur,PAF(0),PAF(1),PAF(2),PAF(3)); }
  #undef PKW
  #undef PAF
  #undef VFR
  #undef PIN
  #undef MX3
  #undef GAPA
  #undef GAPB
  #undef EX
  #undef VRD
  #undef KRD
  #undef STEP
  #undef ENDW
  {auto rr=__builtin_amdgcn_permlane32_swap(__float_as_uint(l_reg),__float_as_uint(l_reg),false,false);l_reg=__uint_as_float(rr[0])+__uint_as_float(rr[1]);}
  if(hi==0){wsf[32+r32]=l_reg; wsf[r32]=mhat+__builtin_amdgcn_logf(l_reg);} asm volatile("s_waitcnt lgkmcnt(0)":::"memory");
  float rli[16];
  #pragma unroll
  for(int r=0;r<16;++r)rli[r]=__builtin_amdgcn_rcpf(wsf[32+crow(r,hi)]);
  { bf16*stg=(bf16*)(shm+LDS_OST)+wid*2048;
    #pragma unroll
    for(int r=0;r<16;++r){const int orow=crow(r,hi);
      #pragma unroll
      for(int d0=0;d0<2;++d0)stg[orow*64+d0*32+r32]=__float2bfloat16(o[d0][r]*rli[r]);}
    asm volatile("s_waitcnt lgkmcnt(0)":::"memory");
    if(!OWN){
      #pragma unroll
      for(int i=0;i<4;++i){const int row=i*8+(lane>>3),ch=lane&7; const u32x4 v=*(const u32x4*)(stg+row*64+ch*8); const int e_=ent[wid*QBLK+row]; const float ls=wsf[row];
        if(e_>=0){ const size_t idx=((size_t)(e_>>2)*16+h)*3+(e_&3); *(u32x4*)(PO+idx*64+ch*8)=v; if(ch==0)LSE[idx]=ls; } }
    } else {
      const int nsel=oblk<3?oblk:3;
      #pragma unroll
      for(int i=0;i<4;++i){const int row=i*8+(lane>>3),ch=lane&7; const u32x4 v=*(const u32x4*)(stg+row*64+ch*8); const float ls=wsf[row];
        const size_t idx0=((size_t)(oblk*256+wid*QBLK+row)*16+h)*3;
        float lr[3]; u32x4 pv_[3]; float M=ls;
        #pragma unroll
        for(int r=0;r<3;++r){ lr[r]=-INFINITY; pv_[r]=(u32x4){0u,0u,0u,0u}; if(r<nsel){ lr[r]=LSE[idx0+r]; pv_[r]=*(const u32x4*)(PO+(idx0+r)*64+ch*8); } M=fmaxf(M,lr[r]); }
        const float w0=__builtin_amdgcn_exp2f(ls-M); float W=w0; float a[8];
        #pragma unroll
        for(int k=0;k<4;++k){ a[2*k]=w0*__uint_as_float(v[k]<<16); a[2*k+1]=w0*__uint_as_float(v[k]&0xffff0000u); }
        #pragma unroll
        for(int r=0;r<3;++r){ const float w=__builtin_amdgcn_exp2f(lr[r]-M); W+=w;
          #pragma unroll
          for(int k=0;k<4;++k){ a[2*k]+=w*__uint_as_float(pv_[r][k]<<16); a[2*k+1]+=w*__uint_as_float(pv_[r][k]&0xffff0000u); } }
        const float iw=1.0f/W; u32x4 ov;
        #pragma unroll
        for(int k=0;k<4;++k) ov[k]=cvtpk_s(a[2*k]*iw,a[2*k+1]*iw);
        *(u32x4*)(O+(kvrow0+wid*QBLK+row)*DM+h*D+ch*8)=ov; }
    } }
  asm volatile("s_waitcnt lgkmcnt(0)\n\ts_barrier":::"memory");
  #undef DMA_K
  #undef DMA_V
  #undef CMASK
  #undef START
  #undef RESC
  #undef ROT
}

#undef SBAR
#undef WAIT_BAR
#undef LAS_I
}
constexpr int NWAVES = 8, NTHREADS = 512;
constexpr int SEQ = 16384, DM_ = 1024, NH = 16, TOK = 2 * SEQ, DFF = 2816, NUP = 2 * DFF;
constexpr size_t MiB = 1u << 20;
constexpr size_t WS_CTL = 0;
constexpr size_t WS_SSQ = 1 * MiB;
constexpr size_t WS_KMEAN = 3 * MiB;
constexpr size_t WS_ROPE = 4 * MiB;
constexpr size_t WS_WIN = 8 * MiB, WS_WOUT = 14 * MiB, WS_WQKV = 16 * MiB, WS_WO = 22 * MiB, WS_WUP0 = 24 * MiB, WS_WUP1 = 35 * MiB;
constexpr size_t WS_WDN0 = 46 * MiB, WS_WDN1 = WS_WDN0 + 5 * MiB + MiB / 2;
constexpr size_t WS_XB = 58 * MiB;
constexpr size_t WS_BIG = 122 * MiB;
constexpr size_t WS_CV = WS_BIG + 64 * MiB, WS_Y1 = WS_BIG + 128 * MiB;
constexpr size_t WS_Q = WS_BIG, WS_K = WS_BIG + 64 * MiB, WS_V = WS_BIG + 128 * MiB, WS_PO = WS_BIG + 192 * MiB, WS_LSE = WS_BIG + 288 * MiB, WS_LIST = WS_BIG + 292 * MiB;
constexpr size_t WS_RAW = WS_BIG + 176 * MiB;
constexpr size_t WS_END = 478 * MiB;
constexpr int LISTH = 516096;
static_assert(WS_WDN1 + (size_t)1024 * DFF * 2 <= WS_XB && WS_XB + (size_t)TOK * 1024 * 2 <= WS_BIG && WS_BIG + (size_t)TOK * DFF * 2 <= WS_RAW && WS_RAW + (size_t)(TOK / 64) * 4 * NUP * 2 <= WS_END, "d_ws map");
static_assert(WS_LIST + (size_t)32 * LISTH * 4 <= WS_END && WS_PO + (size_t)SEQ * 16 * 3 * 64 * 2 <= WS_LSE && WS_LSE + (size_t)SEQ * 16 * 3 * 4 <= WS_LIST, "attention map");
constexpr int RING_BYTES = 131072, LDS_BYTES = 147456, MISC_OFF = RING_BYTES + 512;
constexpr size_t WS_BAR = 16384;
#define LAS __attribute__((address_space(3)))
typedef unsigned short bf16;
typedef unsigned v4u __attribute__((ext_vector_type(4)));
typedef float f32x4 __attribute__((ext_vector_type(4)));
__device__ __forceinline__ unsigned f2bf(float f) { unsigned u = __builtin_bit_cast(unsigned, f); return (u + 0x7fffu + ((u >> 16) & 1u)) >> 16; }
__device__ __forceinline__ unsigned pk2(float lo, float hi) { return f2bf(lo) | (f2bf(hi) << 16); }
__device__ __forceinline__ float bflo(unsigned w) { return __builtin_bit_cast(float, w << 16); }
__device__ __forceinline__ float bfhi(unsigned w) { return __builtin_bit_cast(float, w & 0xffff0000u); }
typedef float f32x2 __attribute__((ext_vector_type(2)));
__device__ __forceinline__ unsigned cvtpk(f32x2 v) { typedef __bf16 bf16x2_t __attribute__((ext_vector_type(2))); const bf16x2_t b = __builtin_convertvector(v, bf16x2_t); return __builtin_bit_cast(unsigned, b); }
__device__ __forceinline__ f32x2 unpk(unsigned w) { return (f32x2){bflo(w), bfhi(w)}; }
__device__ __forceinline__ float wave_sum(float v) {
#pragma unroll
    for (int o = 1; o < 64; o <<= 1) v += __shfl_xor(v, o);
    return v;
}
__device__ __forceinline__ void p0_item(const float* __restrict__ W, int K, int N, bf16* __restrict__ WT, int nrow0, int srccol0, const float* __restrict__ gain, LAS float* scr, int k0, int lane) {
    float wv[32];
#pragma unroll
    for (int i = 0; i < 32; ++i) { const int kk = 2 * i + (lane >> 5); wv[i] = W[(size_t)(k0 + kk) * N + srccol0 + (lane & 31)]; }
    if (gain) {
#pragma unroll
        for (int i = 0; i < 32; ++i) wv[i] *= gain[k0 + 2 * i + (lane >> 5)]; }
#pragma unroll
    for (int i = 0; i < 32; ++i) scr[(2 * i + (lane >> 5)) * 33 + (lane & 31)] = wv[i];
    asm volatile("s_waitcnt lgkmcnt(0)" ::: "memory");
    const int c = lane & 7;
#pragma unroll
    for (int j = 0; j < 4; ++j) { const int n = (lane >> 3) + 8 * j; const LAS float* s = scr + (8 * c) * 33 + n;
        v4u o; o.x = cvtpk((f32x2){s[0 * 33], s[1 * 33]}); o.y = cvtpk((f32x2){s[2 * 33], s[3 * 33]}); o.z = cvtpk((f32x2){s[4 * 33], s[5 * 33]}); o.w = cvtpk((f32x2){s[6 * 33], s[7 * 33]});
        *(v4u*)(WT + (size_t)(nrow0 + n) * K + k0 + 8 * c) = o; }
    asm volatile("s_waitcnt lgkmcnt(0)" ::: "memory");
}
__device__ __forceinline__ int src_in(int n) { if (n < 1024) return n; const int m = n - 1024, t = m >> 8, w = m & 255; return ((w >> 7) ? 2048 : 1024) + t * 128 + (w & 127); }
__device__ __forceinline__ int src_qkv(int n) { const int t = n >> 8; if (t >= 8) return n; const int w = n & 255, bj = w >> 7, wc = (w & 127) >> 5, dd = w & 31; return (t >> 2) * 1024 + ((t & 3) * 4 + wc) * 64 + bj * 32 + dd; }
__device__ __forceinline__ int src_up(int n) { const int t = n >> 8, w = n & 255; return (w >> 7) * DFF + t * 128 + (w & 127); }
__device__ const double ROPE_INV[32] = {1.00000000000000000000e+00, 7.49894209332455874417e-01, 5.62341325190349072827e-01, 4.21696503428582225581e-01, 3.16227766016837941176e-01, 2.37137370566165517349e-01, 1.77827941003892292526e-01, 1.33352143216332402753e-01,
    1.00000000000000005551e-01, 7.49894209332455791150e-02, 5.62341325190349114460e-02, 4.21696503428582239459e-02, 3.16227766016837913421e-02, 2.37137370566165538166e-02, 1.77827941003892292526e-02, 1.33352143216332406223e-02,
    1.00000000000000002082e-02, 7.49894209332455791150e-03, 5.62341325190349097113e-03, 4.21696503428582291501e-03, 3.16227766016837939442e-03, 2.37137370566165538166e-03, 1.77827941003892275179e-03, 1.33352143216332406223e-03,
    1.00000000000000002082e-03, 7.49894209332455856203e-04, 5.62341325190349097113e-04, 4.21696503428582237290e-04, 3.16227766016837939442e-04, 2.37137370566165538166e-04, 1.77827941003892269758e-04, 1.33352143216332395381e-04};
__device__ __forceinline__ void sincos_d(double a, float& sn, float& cs) {
    const double k = __builtin_rint(a * 0.63661977236758134308);
    double r = __builtin_fma(-k, 1.57079632673412561417e+00, a); r = __builtin_fma(-k, 6.07710050650619224932e-11, r);
    const double z = r * r;
    double ps = 1.0 / 6227020800.0;
    ps = __builtin_fma(ps, z, -1.0 / 39916800.0); ps = __builtin_fma(ps, z, 1.0 / 362880.0); ps = __builtin_fma(ps, z, -1.0 / 5040.0); ps = __builtin_fma(ps, z, 1.0 / 120.0); ps = __builtin_fma(ps, z, -1.0 / 6.0); ps = __builtin_fma(ps * z, r, r);
    double pc = -1.0 / 87178291200.0;
    pc = __builtin_fma(pc, z, 1.0 / 479001600.0); pc = __builtin_fma(pc, z, -1.0 / 3628800.0); pc = __builtin_fma(pc, z, 1.0 / 40320.0); pc = __builtin_fma(pc, z, -1.0 / 720.0); pc = __builtin_fma(pc, z, 1.0 / 24.0); pc = __builtin_fma(pc, z, -0.5); pc = __builtin_fma(pc, z, 1.0);
    const int q = (int)k & 3;
    const double s_ = (q & 1) ? pc : ps, c_ = (q & 1) ? ps : pc;
    sn = (float)((q & 2) ? -s_ : s_); cs = (float)((q == 1 || q == 2) ? -c_ : c_);
}
struct Args { const float* in[12]; float* out; unsigned char* ws; };
__device__ __forceinline__ void p0_prologue(const Args& A, unsigned char* ws, LAS unsigned char* lds, int gw, int NGW, int wave, int lane) {
    LAS float* scr = (LAS float*)(lds + wave * 16384);
    constexpr int I_IN = 16 * 96, I_OUT = 16 * 32, I_QKV = 16 * 96, I_O = 16 * 32, I_UP = 16 * 176, I_DN = 44 * 32;
    constexpr int NITEMS = I_IN + I_OUT + I_QKV + I_O + 2 * I_UP + 2 * I_DN;
    for (int it = gw; it < NITEMS; it += NGW) {
        int r = it;
        if (r < I_IN) { const int kb = r / 96, nb = r % 96; p0_item(A.in[2], 1024, 3072, (bf16*)(ws + WS_WIN), 32 * nb, src_in(32 * nb), A.in[1], scr, 64 * kb, lane); continue; } r -= I_IN;
        if (r < I_OUT) { const int kb = r / 32, nb = r % 32; p0_item(A.in[4], 1024, 1024, (bf16*)(ws + WS_WOUT), 32 * nb, 32 * nb, nullptr, scr, 64 * kb, lane); continue; } r -= I_OUT;
        if (r < I_QKV) { const int kb = r / 96, nb = r % 96; p0_item(A.in[5], 1024, 3072, (bf16*)(ws + WS_WQKV), 32 * nb, src_qkv(32 * nb), A.in[1] + 1024, scr, 64 * kb, lane); continue; } r -= I_QKV;
        if (r < I_O) { const int kb = r / 32, nb = r % 32; p0_item(A.in[6], 1024, 1024, (bf16*)(ws + WS_WO), 32 * nb, 32 * nb, nullptr, scr, 64 * kb, lane); continue; } r -= I_O;
        if (r < 2 * I_UP) { const int l = r / I_UP; r -= l * I_UP; const int kb = r / 176, nb = r % 176;
            p0_item(A.in[8] + (size_t)l * 1024 * NUP, 1024, NUP, (bf16*)(ws + (l ? WS_WUP1 : WS_WUP0)), 32 * nb, src_up(32 * nb), A.in[7] + l * 1024, scr, 64 * kb, lane); continue; } r -= 2 * I_UP;
        { const int l = r / I_DN; r -= l * I_DN; const int kb = r / 32, nb = r % 32;
            p0_item(A.in[10] + (size_t)l * DFF * 1024, DFF, 1024, (bf16*)(ws + (l ? WS_WDN1 : WS_WDN0)), 32 * nb, 32 * nb, nullptr, scr, 64 * kb, lane); }
    }
    { const float* x = A.in[0]; bf16* xb = (bf16*)(ws + WS_XB); float* ssq = (float*)(ws + WS_SSQ);
      for (int m0 = gw * 4; m0 < TOK; m0 += NGW * 4) { f32x4 v[4][4]; float sq[4];
#pragma unroll
          for (int q = 0; q < 4; ++q) { const f32x4* xr = (const f32x4*)(x + (size_t)(m0 + q) * 1024) + lane;
#pragma unroll
              for (int j = 0; j < 4; ++j) v[q][j] = xr[64 * j]; }
#pragma unroll
          for (int q = 0; q < 4; ++q) { float s_ = 0.f;
#pragma unroll
              for (int j = 0; j < 4; ++j) s_ += (v[q][j][0] * v[q][j][0] + v[q][j][1] * v[q][j][1]) + (v[q][j][2] * v[q][j][2] + v[q][j][3] * v[q][j][3]);
              sq[q] = wave_sum(s_); }
#pragma unroll
          for (int q = 0; q < 4; ++q) { unsigned long long* o8 = (unsigned long long*)(xb + (size_t)(m0 + q) * 1024) + lane;
#pragma unroll
              for (int j = 0; j < 4; ++j) o8[64 * j] = (unsigned long long)cvtpk((f32x2){v[q][j][0], v[q][j][1]}) | ((unsigned long long)cvtpk((f32x2){v[q][j][2], v[q][j][3]}) << 32);
              if (lane < 16) ssq[(size_t)(m0 + q) * 16 + lane] = lane == 0 ? sq[q] : 0.f; } } }
    { const int gt = gw * 64 + lane, NGT = NGW * 64;
      float* km = (float*)(ws + WS_KMEAN); for (int i = gt; i < 2 * 16 * 64 * 64; i += NGT) km[i] = 0.f;
      unsigned* ctl = (unsigned*)(ws + WS_CTL); for (int i = gt; i < 4096; i += NGT) ctl[i] = 0u;
      float* rc = (float*)(ws + WS_ROPE); float* rsn = rc + SEQ * 32;
      for (int i = gt; i < SEQ * 32; i += NGT) { const int s = i >> 5, f = i & 31; float sn, cs; sincos_d((double)s * ROPE_INV[f], sn, cs); rc[i] = cs; rsn[i] = sn; } }
}
__device__ __forceinline__ void ffn_fix_phase(bf16* __restrict__ ACT, const bf16* __restrict__ RAW, const float* __restrict__ wc  , int gtid, int ngt) {
    constexpr int NCH = DFF / 8;
    for (int task = gtid; task < (TOK / 64) * NCH; task += ngt) { const int run = task / NCH, c = (task % NCH) * 8;
        f32x2 wg[3][4], wu[3][4];
#pragma unroll
        for (int j = 0; j < 3; ++j)
#pragma unroll
            for (int k = 0; k < 4; ++k) { wg[j][k] = *(const f32x2*)(wc + j * NUP + c + 2 * k); wu[j][k] = *(const f32x2*)(wc + j * NUP + DFF + c + 2 * k); }
        v4u gA = {0u, 0u, 0u, 0u}, gB = gA, uA = gA, uB = gA;
        if ((run & 255) != 0) { const bf16* pp = RAW + ((size_t)(run - 1) * 4 + 2) * NUP + c; gA = *(const v4u*)pp; uA = *(const v4u*)(pp + DFF); gB = *(const v4u*)(pp + NUP); uB = *(const v4u*)(pp + NUP + DFF); }
        const bf16* cp = RAW + (size_t)run * 4 * NUP + c; const v4u g0 = *(const v4u*)cp, u0 = *(const v4u*)(cp + DFF), g1 = *(const v4u*)(cp + NUP), u1 = *(const v4u*)(cp + NUP + DFF);
        v4u o0, o1;
#pragma unroll
        for (int k = 0; k < 4; ++k) {
            const f32x2 ga = unpk(gA[k]), gb = unpk(gB[k]), gc0 = unpk(g0[k]), gc1 = unpk(g1[k]), ua = unpk(uA[k]), ub = unpk(uB[k]), uc0 = unpk(u0[k]), uc1 = unpk(u1[k]);
            const f32x2 gv0 = wg[0][k] * ga + wg[1][k] * gb + wg[2][k] * gc0, uv0 = wu[0][k] * ua + wu[1][k] * ub + wu[2][k] * uc0;
            const f32x2 gv1 = wg[0][k] * gb + wg[1][k] * gc0 + wg[2][k] * gc1, uv1 = wu[0][k] * ub + wu[1][k] * uc0 + wu[2][k] * uc1;
            f32x2 e0 = gv0 * -1.4426950408889634f, e1 = gv1 * -1.4426950408889634f;
            e0.x = __builtin_amdgcn_rcpf(1.0f + __builtin_amdgcn_exp2f(e0.x)); e0.y = __builtin_amdgcn_rcpf(1.0f + __builtin_amdgcn_exp2f(e0.y)); e1.x = __builtin_amdgcn_rcpf(1.0f + __builtin_amdgcn_exp2f(e1.x)); e1.y = __builtin_amdgcn_rcpf(1.0f + __builtin_amdgcn_exp2f(e1.y));
            o0[k] = cvtpk(gv0 * e0 * uv0); o1[k] = cvtpk(gv1 * e1 * uv1); }
        *(v4u*)(ACT + (size_t)(run * 64) * DFF + c) = o0; *(v4u*)(ACT + (size_t)(run * 64 + 1) * DFF + c) = o1;
    }
}
__device__ __forceinline__ int list_off(int j) { return j * SEQ - 128 * j * (j + 1); }
typedef short gbf16x8 __attribute__((ext_vector_type(8)));
typedef float gf32x16 __attribute__((ext_vector_type(16)));
__device__ __forceinline__ bool gate_better(float a, int ja, float b, int jb) { return a > b || (a == b && ja < jb); }
__device__ __forceinline__ void gate_unit_params(int u, int G, int& b, int& h, int& chunk) {
    b = u >> 9; h = (u >> 5) & 15; chunk = u & 31;
    if (G == 256) { const int k = u >> 8, base = ((u & 31) + 16 * (k >> 1)) & 31; chunk = (k & 1) ? 31 - base : base; }
}
__device__ __forceinline__ void gate_phase(const bf16* __restrict__ Q, const float* __restrict__ kmean, unsigned* cnt, int* list, LAS unsigned char* lds, int tid) {
    constexpr int KMS = 144; LAS unsigned char* kmh = lds; LAS unsigned char* kml = lds + 64 * KMS;
    LAS int* hist = (LAS int*)(lds + 20480); LAS int* gbase = (LAS int*)(lds + 20480 + 256);
    const int lane = tid & 63, r32 = lane & 31, hi = lane >> 5, wid = __builtin_amdgcn_readfirstlane(tid >> 6);
    const int krow = tid >> 3, kcol = (tid & 7) * 8, G = gridDim.x; constexpr int NU = 2 * 16 * 32;
    f32x4 pk0 = {0.f, 0.f, 0.f, 0.f}, pk1 = pk0; gbf16x8 pq[2][4];
#pragma unroll
    for (int ct = 0; ct < 2; ++ct)
#pragma unroll
        for (int ks = 0; ks < 4; ++ks) pq[ct][ks] = gbf16x8{};
#define GATE_LOAD(uu) do { int b_, h_, c_; gate_unit_params((uu), G, b_, h_, c_); const float* kb_ = kmean + (size_t)(b_ * 16 + h_) * 4096 + krow * 64 + kcol; pk0 = *(const f32x4*)kb_; pk1 = *(const f32x4*)(kb_ + 4); \
        if (2 * c_ + (wid >> 2) > 0) { _Pragma("unroll") for (int ct = 0; ct < 2; ++ct) { const bf16* qp_ = Q + ((size_t)b_ * SEQ + c_ * 512 + wid * 64 + ct * 32 + r32) * 1024 + h_ * 64 + 8 * hi; \
            _Pragma("unroll") for (int ks = 0; ks < 4; ++ks) pq[ct][ks] = *(const gbf16x8*)(qp_ + 16 * ks); } } } while (0)
    int u = blockIdx.x;
    if (u < NU) GATE_LOAD(u);
    for (; u < NU; u += G) { int b, h, chunk; gate_unit_params(u, G, b, h, chunk);
        const f32x4 ck0 = pk0, ck1 = pk1; gbf16x8 cq[2][4];
#pragma unroll
        for (int ct = 0; ct < 2; ++ct)
#pragma unroll
            for (int ks = 0; ks < 4; ++ks) cq[ct][ks] = pq[ct][ks];
        __syncthreads();
        { v4u wh, wl;
#pragma unroll
          for (int k = 0; k < 4; ++k) { const f32x2 x = k < 2 ? (f32x2){ck0[2 * k], ck0[2 * k + 1]} : (f32x2){ck1[2 * k - 4], ck1[2 * k - 3]}; const unsigned w = cvtpk(x); wh[k] = w; wl[k] = cvtpk(x - unpk(w)); }
          *(LAS v4u*)(kmh + krow * KMS + kcol * 2) = wh; *(LAS v4u*)(kml + krow * KMS + kcol * 2) = wl; }
        if (tid < 64) hist[tid] = 0;
        __syncthreads();
        if (u + G < NU) GATE_LOAD(u + G);
        const int own = 2 * chunk + (wid >> 2);
        const int nsel = own < 3 ? own : 3;
        int si[2][3], sp[2][3];
#pragma unroll
        for (int ct = 0; ct < 2; ++ct)
#pragma unroll
            for (int r = 0; r < 3; ++r) { si[ct][r] = 0; sp[ct][r] = 0; }
        if (own > 0) {
            gbf16x8 ah[2][4], al[2][4];
#pragma unroll
            for (int jt = 0; jt < 2; ++jt)
#pragma unroll
                for (int ks = 0; ks < 4; ++ks) { const int off = (32 * jt + r32) * KMS + (16 * ks + 8 * hi) * 2; ah[jt][ks] = *(const LAS gbf16x8*)(kmh + off); al[jt][ks] = *(const LAS gbf16x8*)(kml + off); }
#pragma unroll
            for (int ct = 0; ct < 2; ++ct) {
                gbf16x8 qf[4];
#pragma unroll
                for (int ks = 0; ks < 4; ++ks) qf[ks] = cq[ct][ks];
                gf32x16 acc[2];
#pragma unroll
                for (int jt = 0; jt < 2; ++jt) { acc[jt] = gf32x16{};
#pragma unroll
                    for (int ks = 0; ks < 4; ++ks) { acc[jt] = __builtin_amdgcn_mfma_f32_32x32x16_bf16(al[jt][ks], qf[ks], acc[jt], 0, 0, 0); acc[jt] = __builtin_amdgcn_mfma_f32_32x32x16_bf16(ah[jt][ks], qf[ks], acc[jt], 0, 0, 0); } }
                float v1 = -3.0e38f, v2 = -3.0e38f, v3 = -3.0e38f; int i1 = 0, i2 = 0, i3 = 0;
#pragma unroll
                for (int jt = 0; jt < 2; ++jt)
#pragma unroll
                    for (int r = 0; r < 16; ++r) { const int j = 32 * jt + (r & 3) + 8 * (r >> 2) + 4 * hi; const float g = j < own ? acc[jt][r] : -3.0e38f;
                        if (g > v1) { v3 = v2; i3 = i2; v2 = v1; i2 = i1; v1 = g; i1 = j; } else if (g > v2) { v3 = v2; i3 = i2; v2 = g; i2 = j; } else if (g > v3) { v3 = g; i3 = j; } }
                float a_[3], b_[3]; int ja[3], jb[3];
                { auto r1 = __builtin_amdgcn_permlane32_swap(__float_as_uint(v1), __float_as_uint(v1), false, false); a_[0] = __uint_as_float(r1[0]); b_[0] = __uint_as_float(r1[1]);
                  auto r2 = __builtin_amdgcn_permlane32_swap(__float_as_uint(v2), __float_as_uint(v2), false, false); a_[1] = __uint_as_float(r2[0]); b_[1] = __uint_as_float(r2[1]);
                  auto r3 = __builtin_amdgcn_permlane32_swap(__float_as_uint(v3), __float_as_uint(v3), false, false); a_[2] = __uint_as_float(r3[0]); b_[2] = __uint_as_float(r3[1]);
                  auto q1 = __builtin_amdgcn_permlane32_swap((unsigned)i1, (unsigned)i1, false, false); ja[0] = (int)q1[0]; jb[0] = (int)q1[1];
                  auto q2 = __builtin_amdgcn_permlane32_swap((unsigned)i2, (unsigned)i2, false, false); ja[1] = (int)q2[0]; jb[1] = (int)q2[1];
                  auto q3 = __builtin_amdgcn_permlane32_swap((unsigned)i3, (unsigned)i3, false, false); ja[2] = (int)q3[0]; jb[2] = (int)q3[1]; }
                int m_[3];
                {
                  float ca = a_[0], cb = b_[0]; int cja = ja[0], cjb = jb[0]; int pa = 0, pb = 0;
#pragma unroll
                  for (int r = 0; r < 3; ++r) { const bool ta = gate_better(ca, cja, cb, cjb); m_[r] = ta ? cja : cjb;
                      if (ta) { ++pa; ca = pa == 1 ? a_[1] : pa == 2 ? a_[2] : -3.3e38f; cja = pa == 1 ? ja[1] : pa == 2 ? ja[2] : 1 << 20; }
                      else    { ++pb; cb = pb == 1 ? b_[1] : pb == 2 ? b_[2] : -3.3e38f; cjb = pb == 1 ? jb[1] : pb == 2 ? jb[2] : 1 << 20; } } }
                si[ct][0] = m_[0]; si[ct][1] = m_[1]; si[ct][2] = m_[2];
                if (hi == 0) {
                    sp[ct][0] = __hip_atomic_fetch_add(hist + m_[0], 1, __ATOMIC_RELAXED, __HIP_MEMORY_SCOPE_WORKGROUP);
                    if (nsel > 1) sp[ct][1] = __hip_atomic_fetch_add(hist + m_[1], 1, __ATOMIC_RELAXED, __HIP_MEMORY_SCOPE_WORKGROUP);
                    if (nsel > 2) sp[ct][2] = __hip_atomic_fetch_add(hist + m_[2], 1, __ATOMIC_RELAXED, __HIP_MEMORY_SCOPE_WORKGROUP); }
            }
        }
        __syncthreads();
        if (tid < 64) { const int c = hist[tid]; gbase[tid] = c > 0 ? (int)__hip_atomic_fetch_add(cnt + (b * 16 + h) * 64 + tid, (unsigned)c, __ATOMIC_RELAXED, __HIP_MEMORY_SCOPE_AGENT) : 0; }
        __syncthreads();
        if (own > 0 && hi == 0) { int* lb = list + (size_t)(b * 16 + h) * LISTH;
#pragma unroll
            for (int ct = 0; ct < 2; ++ct) { const int t = chunk * 512 + wid * 64 + ct * 32 + r32;
                lb[list_off(si[ct][0]) + gbase[si[ct][0]] + sp[ct][0]] = (t << 2) | 0;
                if (nsel > 1) lb[list_off(si[ct][1]) + gbase[si[ct][1]] + sp[ct][1]] = (t << 2) | 1;
                if (nsel > 2) lb[list_off(si[ct][2]) + gbase[si[ct][2]] + sp[ct][2]] = (t << 2) | 2; } }
    }
}
constexpr int ATT_ENT_OFF = attn_body::LDS_BYTES, ATT_PFX_OFF = attn_body::LDS_BYTES + 2048;
__device__ __forceinline__ void attn_sel_phase(int b, const unsigned* cnt, const int* list, const attn_body::bf16* Q, const attn_body::bf16* K, const attn_body::bf16* V, attn_body::bf16* PO, float* LSE, unsigned char* ldsg, int tid) {
    LAS int* ent = (LAS int*)((LAS unsigned char*)ldsg + ATT_ENT_OFF); LAS int* pfx = (LAS int*)((LAS unsigned char*)ldsg + ATT_PFX_OFF);
    __syncthreads();
    {
        const int c0 = (int)cnt[b * 1024 + 2 * tid], c1 = (int)cnt[b * 1024 + 2 * tid + 1]; const int a0 = (c0 + 255) >> 8, a1 = (c1 + 255) >> 8;
        const int lane_ = tid & 63, wv_ = tid >> 6; int inc = a0 + a1;
#pragma unroll
        for (int o_ = 1; o_ < 64; o_ <<= 1) { const int v_ = __shfl_up(inc, o_); if (lane_ >= o_) inc += v_; }
        LAS int* wtot = pfx + 1024;
        if (lane_ == 63) wtot[wv_] = inc;
        __syncthreads();
        int off_ = 0;
#pragma unroll
        for (int w_ = 0; w_ < 8; ++w_) off_ += (w_ < wv_) ? wtot[w_] : 0;
        const int excl = off_ + inc - (a0 + a1);
        pfx[2 * tid] = excl + a0; pfx[2 * tid + 1] = excl + a0 + a1;
        __syncthreads();
    }
    const int total = pfx[1023];
#define SEL_INFO(gg, l_, k_, h_, j_, n_) do { int lo_ = 0, hi_ = 1023; while (lo_ < hi_) { const int mid_ = (lo_ + hi_) >> 1; if (pfx[mid_] > (gg)) hi_ = mid_; else lo_ = mid_ + 1; } \
        l_ = lo_; k_ = (gg) - (lo_ ? pfx[lo_ - 1] : 0); h_ = lo_ >> 6; j_ = lo_ & 63; n_ = (int)cnt[b * 1024 + lo_]; } while (0)
    int g = blockIdx.x;
    if (g < total) {
        LAS int* ent_cur = ent; LAS int* ent_nxt = ent + 256;
        int l, k, h, j, n; SEL_INFO(g, l, k, h, j, n);
        if (tid < 256) { const int e = k * 256 + tid; ent_cur[tid] = e < n ? list[(size_t)(b * 16 + h) * LISTH + list_off(j) + e] : -1; }
        __syncthreads();
        bool pref = false; attn_body::bf16x8 qr[4];
        for (;;) {
            const int gn = g + gridDim.x; const bool hn = gn < total; int ln = 0, kn = 0, h2 = 0, j2 = 0, nn = 0, e_next = -1;
            if (hn) { SEL_INFO(gn, ln, kn, h2, j2, nn); if (tid < 256) { const int e = kn * 256 + tid; if (e < nn) e_next = list[(size_t)(b * 16 + h2) * LISTH + list_off(j2) + e]; } }
            attn_body::attn_unit<8, false>((long)b * SEQ + j * 256, h, ent_cur, (long)b * SEQ, 0, Q, K, V, PO, LSE, nullptr, (char*)ldsg, pref, hn, (long)b * SEQ + j2 * 256, h2, ent_nxt, e_next, qr);
            if (!hn) break;
            { LAS int* t_ = ent_cur; ent_cur = ent_nxt; ent_nxt = t_; }
            g = gn; h = h2; j = j2; pref = true; (void)ln; (void)l;
        }
    }
#undef SEL_INFO
}
__device__ __forceinline__ void attn_own_phase(int b, const attn_body::bf16* Q, const attn_body::bf16* K, const attn_body::bf16* V, attn_body::bf16* PO, float* LSE, attn_body::bf16* O, unsigned char* ldsg) {
    __syncthreads();
    bool pref = false; attn_body::bf16x8 qr[4];
    for (int g = blockIdx.x; g < 16 * 64; g += gridDim.x) { const int h = g >> 6, o = 63 - (g & 63); const int gn = g + gridDim.x; const bool hn = gn < 16 * 64; const int h2 = gn >> 6, o2 = 63 - (gn & 63);
        attn_body::attn_unit<8, true>((long)b * SEQ + o * 256, h, nullptr, (long)b * SEQ, o, Q, K, V, PO, LSE, O, (char*)ldsg, pref, hn, (long)b * SEQ + o2 * 256, h2, nullptr, 0, qr); pref = true; }
}
__device__ __forceinline__ void final_norm_phase(float* out, const bf16* __restrict__ xb, const float* __restrict__ ssq, const float* __restrict__ gain, int gw, int NGW, int lane) {
    f32x4 g0 = ((const f32x4*)gain)[2 * lane], g1 = ((const f32x4*)gain)[2 * lane + 1], g2 = ((const f32x4*)gain)[128 + 2 * lane], g3 = ((const f32x4*)gain)[128 + 2 * lane + 1];
    for (int m0 = gw * 8; m0 < TOK; m0 += NGW * 8) { v4u v[8][2]; float rs[8];
#pragma unroll
        for (int q = 0; q < 8; ++q) { const v4u* xr = (const v4u*)(xb + (size_t)(m0 + q) * 1024) + lane; v[q][0] = xr[0]; v[q][1] = xr[64]; rs[q] = pg8::row_rstd(ssq, m0 + q); }
#pragma unroll
        for (int q = 0; q < 8; ++q) { f32x4* o = (f32x4*)(out + (size_t)(m0 + q) * 1024) + 2 * lane;
            o[0] = (f32x4){bflo(v[q][0].x), bfhi(v[q][0].x), bflo(v[q][0].y), bfhi(v[q][0].y)} * rs[q] * g0; o[1] = (f32x4){bflo(v[q][0].z), bfhi(v[q][0].z), bflo(v[q][0].w), bfhi(v[q][0].w)} * rs[q] * g1;
            o[128] = (f32x4){bflo(v[q][1].x), bfhi(v[q][1].x), bflo(v[q][1].y), bfhi(v[q][1].y)} * rs[q] * g2; o[129] = (f32x4){bflo(v[q][1].z), bfhi(v[q][1].z), bflo(v[q][1].w), bfhi(v[q][1].w)} * rs[q] * g3; } }
}
#define XB_TMO      128
#define XB_XCNT(j)  (256  + 64 * (j))
#define XB_XSUB(j)  (1280 + 64 * (j))
#define XB_XGEN(j)  (2304 + 64 * (j))
#define XB_TOP      3328
#define XB_TOPGEN   3392
#define XCD_BAR_WORDS 3456
#define XB_SPIN_CAP (1u << 18)

__device__ __forceinline__ unsigned xb_ld(unsigned* p)              { return __hip_atomic_load(p, __ATOMIC_RELAXED, __HIP_MEMORY_SCOPE_AGENT); }
__device__ __forceinline__ unsigned xb_add(unsigned* p, unsigned v) { return __hip_atomic_fetch_add(p, v, __ATOMIC_RELAXED, __HIP_MEMORY_SCOPE_AGENT); }
__device__ __forceinline__ unsigned xb_xcc_id() { return (unsigned)__builtin_amdgcn_s_getreg((3 << 11) | 20) & 0xFu; }
#define XB_SPIN(cond, bar) do { unsigned _sp = 0; while (cond) { __builtin_amdgcn_s_sleep(1); \
    if ((++_sp & 255u) == 0u) { if (xb_ld(&(bar)[XB_TMO])) break; if (_sp > XB_SPIN_CAP) { atomicAdd(&(bar)[XB_TMO], 1u); break; } } } } while (0)

struct XcdBarrier {
    unsigned* bar; unsigned x;
    volatile LAS unsigned* st;
};

__device__ __forceinline__ XcdBarrier xcd_barrier_post(unsigned* bar, volatile LAS unsigned* st) {
    XcdBarrier b; b.bar = bar; b.x = xb_xcc_id(); b.st = st;
    if (threadIdx.x == 0) (void)xb_add(&bar[XB_XCNT(b.x)], 1u);
    return b;
}
__device__ __forceinline__ void xcd_barrier_complete(unsigned* bar, unsigned x, unsigned& nloc, unsigned& nx) {
    const unsigned G = gridDim.x * gridDim.y * gridDim.z;
    unsigned sum, cnt, mine, sp = 0u;
    for (;;) {
        sum = 0u; cnt = 0u; mine = 0u;
#pragma unroll
        for (unsigned j = 0; j < 16; ++j) { const unsigned c = xb_ld(&bar[XB_XCNT(j)]); sum += c; cnt += (c > 0u) ? 1u : 0u; mine = (j == x) ? c : mine; }
        if (sum == G) break;
        __builtin_amdgcn_s_sleep(1);
        if ((++sp & 255u) == 0u) { if (xb_ld(&bar[XB_TMO])) break; if (sp > XB_SPIN_CAP) { atomicAdd(&bar[XB_TMO], 1u); break; } }
    }
    nloc = mine > 0u ? mine : 1u; nx = cnt > 0u ? cnt : 1u;
}

__device__ __forceinline__ void xcd_barrier(const XcdBarrier& b) {
    asm volatile("s_waitcnt vmcnt(0)" ::: "memory");
    __syncthreads();
    if (threadIdx.x == 0) {
        unsigned* bar = b.bar;
        __builtin_amdgcn_s_waitcnt(0);
        unsigned nloc = b.st[0], nx = b.st[1];
        if (nloc == 0u) { xcd_barrier_complete(bar, b.x, nloc, nx); b.st[0] = nloc; b.st[1] = nx; }
        const unsigned old = xb_add(&bar[XB_XSUB(b.x)], 1u);
        const unsigned gen = old / nloc;
        if (old + 1u == (gen + 1u) * nloc) {
            __builtin_amdgcn_fence(__ATOMIC_RELEASE, "agent");
            asm volatile("s_waitcnt vmcnt(0)" ::: "memory");
            const unsigned og = xb_add(&bar[XB_TOP], 1u);
            const unsigned tg = og / nx;
            if (og + 1u == (tg + 1u) * nx) xb_add(&bar[XB_TOPGEN], 1u);
            else XB_SPIN(xb_ld(&bar[XB_TOPGEN]) == tg, bar);
            __builtin_amdgcn_fence(__ATOMIC_ACQUIRE, "agent");
            xb_add(&bar[XB_XGEN(b.x)], 1u);
            asm volatile("s_waitcnt vmcnt(0)" ::: "memory");
        } else {
            XB_SPIN(xb_ld(&bar[XB_XGEN(b.x)]) == gen, bar);
            __builtin_amdgcn_fence(__ATOMIC_ACQUIRE, "agent");
            asm volatile("s_waitcnt vmcnt(0)" ::: "memory");
        }
    }
    __syncthreads();
}

#define PH_VARS unsigned char* ws = A.ws; asm volatile("" : "+s"(ws)); int tid = threadIdx.x; asm volatile("" : "+v"(tid)); const int lane = tid & 63, wave = __builtin_amdgcn_readfirstlane(tid >> 6); \
    const int G = gridDim.x, bx = blockIdx.x; const int gw = bx * NWAVES + wave, NGW = G * NWAVES, gtid = bx * NTHREADS + tid, NGT = G * NTHREADS; (void)lane; (void)gw; (void)NGW; (void)gtid; (void)NGT; \
    float* ssq = (float*)(ws + WS_SSQ); bf16* XB = (bf16*)(ws + WS_XB); float* out = A.out; bf16* ACT = (bf16*)(ws + WS_BIG); bf16* RAW = (bf16*)(ws + WS_RAW); (void)ssq; (void)XB; (void)out; (void)ACT; (void)RAW;
__global__ void __launch_bounds__(NTHREADS, 2) mk_fwd(Args A) {
    extern __shared__ __attribute__((aligned(16))) unsigned char lds[];
    cg::grid_group grid = cg::this_grid();
    LAS unsigned char* L = (LAS unsigned char*)lds;
    if (threadIdx.x < 64) ((LAS unsigned*)(L + RING_BYTES))[threadIdx.x * 4 + 0] = 0u, ((LAS unsigned*)(L + RING_BYTES))[threadIdx.x * 4 + 1] = 0u, ((LAS unsigned*)(L + RING_BYTES))[threadIdx.x * 4 + 2] = 0u, ((LAS unsigned*)(L + RING_BYTES))[threadIdx.x * 4 + 3] = 0u;
    __syncthreads();
    const XcdBarrier bar = xcd_barrier_post((unsigned*)(A.ws + WS_BAR), (volatile LAS unsigned*)(L + MISC_OFF));
#define GSYNC() xcd_barrier(bar)
#define RTAB ((LAS float*)(L + RING_BYTES + 1024))
    { PH_VARS p0_prologue(A, ws, L, gw, NGW, wave, lane); }
    if (gridDim.x == 0x7fffffffu) grid.sync();
    GSYNC();
    { PH_VARS pg8::Gemm g{XB, (const bf16*)(ws + WS_WIN) + (size_t)1024 * 1024, TOK, 2048, 1024, 1024}; pg8::StaticOrder S; S.init(TOK, 2048, G, bx, ssq, RTAB);
      pg8::EpiCV E{RTAB, (bf16*)(ws + WS_CV)};
      pg8::gemm_phase<pg8::EpiCV, pg8::StaticOrder, true, true>(L, g, S, E); }
    GSYNC();
    { PH_VARS pg8::Gemm g{XB, (const bf16*)(ws + WS_WIN), TOK, 1024, 1024, 1024}; pg8::StaticOrder S; S.init(TOK, 1024, G, bx, ssq, RTAB);
      pg8::EpiGate E{RTAB, (const bf16*)(ws + WS_CV), A.in[3], (bf16*)(ws + WS_Y1)};
      pg8::gemm_phase<pg8::EpiGate, pg8::StaticOrder, true, true>(L, g, S, E); }
    GSYNC();
    { PH_VARS pg8::Gemm g{(const bf16*)(ws + WS_Y1), (const bf16*)(ws + WS_WOUT), TOK, 1024, 1024, 1024}; pg8::StaticOrder S; S.init(TOK, 1024, G, bx);
      pg8::EpiRes<false> E{nullptr, XB, ssq};
      pg8::gemm_phase<pg8::EpiRes<false>, pg8::StaticOrder, true, true>(L, g, S, E); }
    GSYNC();
#pragma nounroll
    for (int layer_ = 0; layer_ < 2; ++layer_) {
        int layer = layer_; asm volatile("" : "+s"(layer));
        if (layer == 1) {
            { PH_VARS pg8::Gemm g{XB, (const bf16*)(ws + WS_WQKV), TOK, 3072, 1024, 1024}; pg8::StaticOrder S; S.init(TOK, 3072, G, bx, ssq, RTAB);
              pg8::EpiQkv E{RTAB, (bf16*)(ws + WS_Q), (bf16*)(ws + WS_K), (bf16*)(ws + WS_V), (const float*)(ws + WS_ROPE), (const float*)(ws + WS_ROPE) + SEQ * 32, (float*)(ws + WS_KMEAN)};
              pg8::gemm_phase<pg8::EpiQkv, pg8::StaticOrder, true, true>(L, g, S, E); }
            GSYNC();
            { PH_VARS gate_phase((const bf16*)(ws + WS_Q), (const float*)(ws + WS_KMEAN), (unsigned*)(ws + WS_CTL), (int*)(ws + WS_LIST), L, tid); }
#pragma nounroll
            for (int b_ = 0; b_ < 2; ++b_) {
                int b = b_; asm volatile("" : "+s"(b));
                GSYNC();
                { PH_VARS attn_sel_phase(b, (const unsigned*)(ws + WS_CTL), (const int*)(ws + WS_LIST), (const attn_body::bf16*)(ws + WS_Q), (const attn_body::bf16*)(ws + WS_K), (const attn_body::bf16*)(ws + WS_V),
                                 (attn_body::bf16*)(ws + WS_PO), (float*)(ws + WS_LSE), lds, tid); }
                GSYNC();
                { PH_VARS attn_own_phase(b, (const attn_body::bf16*)(ws + WS_Q), (const attn_body::bf16*)(ws + WS_K), (const attn_body::bf16*)(ws + WS_V), (attn_body::bf16*)(ws + WS_PO), (float*)(ws + WS_LSE), (attn_body::bf16*)(ws + WS_Q), lds); }
            }
            GSYNC();
            { PH_VARS pg8::Gemm g{(const bf16*)(ws + WS_Q), (const bf16*)(ws + WS_WO), TOK, 1024, 1024, 1024}; pg8::StaticOrder S; S.init(TOK, 1024, G, bx);
              pg8::EpiRes<false> E{nullptr, XB, ssq};
              pg8::gemm_phase<pg8::EpiRes<false>, pg8::StaticOrder, true, true>(L, g, S, E); }
            GSYNC();
        }
        { PH_VARS pg8::Gemm g{XB, (const bf16*)(ws + (layer ? WS_WUP1 : WS_WUP0)), TOK, NUP, 1024, 1024}; pg8::StaticOrder S; S.init(TOK, NUP, G, bx, ssq, RTAB);
          pg8::EpiUpAct E{RTAB, ACT, RAW, A.in[9] + (size_t)layer * 3 * NUP};
          pg8::gemm_phase<pg8::EpiUpAct, pg8::StaticOrder, true, true>(L, g, S, E); }
        GSYNC();
        { PH_VARS ffn_fix_phase(ACT, RAW, A.in[9] + (size_t)layer * 3 * NUP, gtid, NGT); }
        GSYNC();
        { PH_VARS pg8::Gemm g{ACT, (const bf16*)(ws + (layer ? WS_WDN1 : WS_WDN0)), TOK, 1024, DFF, DFF}; pg8::StaticOrder S; S.init(TOK, 1024, G, bx);
          pg8::EpiRes<false> E{nullptr, XB, ssq};
          pg8::gemm_phase<pg8::EpiRes<false>, pg8::StaticOrder, true, true>(L, g, S, E); }
        GSYNC();
    }
    { PH_VARS final_norm_phase(out, XB, ssq, A.in[11], gw, NGW, lane); }
}

extern "C" void kernel_launch(void* const* d_in, const int* in_sizes, int n_in, void* d_out, int out_size, void* d_ws, size_t ws_size, hipStream_t stream) {
    static int grid = 0;
    if (grid == 0) {
        if (n_in != 12 || in_sizes[0] != TOK * 1024 || out_size != TOK * 1024 || ws_size < WS_END) { fprintf(stderr, "kernel_launch: unexpected shapes / workspace (n_in %d, in0 %d, out %d, ws %zu, need %zu)\n", n_in, n_in > 0 ? in_sizes[0] : -1, out_size, ws_size, (size_t)WS_END); grid = -1; return; }
        int dev = 0, cus = 0, per_cu = 0;
        if (hipGetDevice(&dev) != hipSuccess || hipDeviceGetAttribute(&cus, hipDeviceAttributeMultiprocessorCount, dev) != hipSuccess) { grid = -1; return; }
        if (hipFuncSetAttribute((const void*)mk_fwd, hipFuncAttributeMaxDynamicSharedMemorySize, LDS_BYTES) != hipSuccess) { fprintf(stderr, "kernel_launch: hipFuncSetAttribute failed\n"); grid = -1; return; }
        if (hipOccupancyMaxActiveBlocksPerMultiprocessor(&per_cu, (const void*)mk_fwd, NTHREADS, LDS_BYTES) != hipSuccess || per_cu < 1) { fprintf(stderr, "kernel_launch: occupancy query says %d\n", per_cu); per_cu = 1; }
        (void)hipGetLastError();
        grid = cus;
    }
    if (grid < 0) return;
    Args a{};
    for (int i = 0; i < 12; ++i) a.in[i] = (const float*)d_in[i];
    a.out = (float*)d_out; a.ws = (unsigned char*)d_ws;
    if (hipMemsetAsync((char*)d_ws + WS_BAR, 0, XCD_BAR_WORDS * 4, stream) != hipSuccess) { fprintf(stderr, "kernel_launch: memset failed\n"); return; }
    void* args[] = {&a};
    hipError_t e = hipLaunchCooperativeKernel((const void*)mk_fwd, dim3(grid), dim3(NTHREADS), args, LDS_BYTES, stream);
    if (e != hipSuccess) fprintf(stderr, "kernel_launch: cooperative launch failed: %s (grid %d)\n", hipGetErrorString(e), grid);
}
```
